# Optimizing an MI355X kernel written in HIP

```python
import math
import jax, jax.numpy as jnp
from jax import lax
import numpy as np

D_MODEL = 1024
BATCH = 4
SEQ = 4096
DEPTH = 2

GRID_W = 64
CTX_LEN = 256
HEAD_DIM = 64
EPS = 1e-6
NEG = -1e30
FOURIER_WIDTH = D_MODEL // 2
FOURIER_GROUPS = 4
FOURIER_GROUP_CH = FOURIER_WIDTH // FOURIER_GROUPS
WIN_Q_HEADS = (D_MODEL // 2) // HEAD_DIM
WIN_KV_HEADS = 2
WIN_RADIUS = 128
WIN_BLOCK = 128
EV_IN_WIDTH = FOURIER_WIDTH + (WIN_Q_HEADS + 2 * WIN_KV_HEADS) * HEAD_DIM
EV_OUT_WIDTH = FOURIER_WIDTH + WIN_Q_HEADS * HEAD_DIM
NA_HEADS = D_MODEL // HEAD_DIM
NA_KH = 8
NA_KW = 16
ROPE_THETA = 10000.0
ROPE_FREQS = HEAD_DIM // 4
D_FF = ((8 * D_MODEL // 3 + 255) // 256) * 256
N_EVEN = (DEPTH + 1) // 2
N_ODD = DEPTH // 2

kernel_name = "hybrid_fourier_window_natten_dit"


def _rms(x, g):
    x32 = x.astype(jnp.float32)
    y = x32 * lax.rsqrt(jnp.mean(x32 * x32, axis=-1, keepdims=True) + EPS)
    return (y * g.astype(jnp.float32)).astype(x.dtype)


def _axial_angles(L):
    t = jnp.arange(L, dtype=jnp.int32)
    row = (t // GRID_W).astype(jnp.float32)
    col = (t % GRID_W).astype(jnp.float32)
    inv = ROPE_THETA ** (-jnp.arange(ROPE_FREQS, dtype=jnp.float32) / ROPE_FREQS)
    return row[:, None] * inv[None, :], col[:, None] * inv[None, :]


def _rotate(xa, ang):
    cos = jnp.cos(ang)[:, None, :].astype(xa.dtype)
    sin = jnp.sin(ang)[:, None, :].astype(xa.dtype)
    x1, x2 = xa[..., :ROPE_FREQS], xa[..., ROPE_FREQS:]
    return jnp.concatenate([x1 * cos - x2 * sin, x2 * cos + x1 * sin], axis=-1)


def _rope_2d(x, ang_row, ang_col):
    h = HEAD_DIM // 2
    return jnp.concatenate([_rotate(x[..., :h], ang_row), _rotate(x[..., h:], ang_col)], axis=-1)


def _fourier_mix(f):
    B, L, _ = f.shape
    fg = f.astype(jnp.float32).reshape(B, L, FOURIER_GROUPS, FOURIER_GROUP_CH)
    mixed = jnp.fft.fft2(fg, axes=(1, 3), norm="ortho").real
    return mixed.reshape(B, L, FOURIER_WIDTH).astype(f.dtype)


def _ctx_attention(q, k, v, sink):
    B, C, H, d = q.shape
    KV = k.shape[2]
    G = H // KV
    qg = q.reshape(B, C, KV, G, d)
    s = jnp.einsum('bqkgd,bjkd->bkgqj', qg, k).astype(jnp.float32) * (1.0 / math.sqrt(d))
    if sink is not None:
        sk = jnp.broadcast_to(sink.astype(jnp.float32).reshape(1, KV, G, 1, 1), (B, KV, G, C, 1))
        p = jax.nn.softmax(jnp.concatenate([s, sk], axis=-1), axis=-1)[..., :C]
    else:
        p = jax.nn.softmax(s, axis=-1)
    o = jnp.einsum('bkgqj,bjkd->bqkgd', p.astype(v.dtype), v)
    return o.reshape(B, C, H * d)


def _window_attention(q, k, v, k_ctx, v_ctx, sink):
    B, L, H, d = q.shape
    KV = k.shape[2]
    G = H // KV
    C = k_ctx.shape[1]
    nb = L // WIN_BLOCK
    nw = 3 * WIN_BLOCK
    scale = 1.0 / math.sqrt(d)
    qb = q.reshape(B, nb, WIN_BLOCK, KV, G, d)
    pad = ((0, 0), (WIN_BLOCK, WIN_BLOCK), (0, 0), (0, 0))
    kp = jnp.pad(k, pad).reshape(B, nb + 2, WIN_BLOCK, KV, d)
    vp = jnp.pad(v, pad).reshape(B, nb + 2, WIN_BLOCK, KV, d)
    kw = jnp.concatenate([kp[:, :-2], kp[:, 1:-1], kp[:, 2:]], axis=2)
    vw = jnp.concatenate([vp[:, :-2], vp[:, 1:-1], vp[:, 2:]], axis=2)
    s_win = jnp.einsum('bnqkgd,bnjkd->bnkgqj', qb, kw).astype(jnp.float32) * scale
    s_ctx = jnp.einsum('bnqkgd,bjkd->bnkgqj', qb, k_ctx).astype(jnp.float32) * scale
    blk = jnp.arange(nb, dtype=jnp.int32)[:, None, None] * WIN_BLOCK
    qpos = blk + jnp.arange(WIN_BLOCK, dtype=jnp.int32)[None, :, None]
    kpos = blk - WIN_BLOCK + jnp.arange(nw, dtype=jnp.int32)[None, None, :]
    mask = (jnp.abs(kpos - qpos) <= WIN_RADIUS) & (kpos >= 0) & (kpos < L)
    s_win = jnp.where(mask[None, :, None, None], s_win, NEG)
    sk = jnp.broadcast_to(sink.astype(jnp.float32).reshape(1, 1, KV, G, 1, 1), (B, nb, KV, G, WIN_BLOCK, 1))
    p = jax.nn.softmax(jnp.concatenate([s_win, s_ctx, sk], axis=-1), axis=-1).astype(v.dtype)
    o = (jnp.einsum('bnkgqj,bnjkd->bnqkgd', p[..., :nw], vw)
         + jnp.einsum('bnkgqj,bjkd->bnqkgd', p[..., nw:nw + C], v_ctx))
    return o.reshape(B, L, H * d)


def _neighbourhood_attention(q, k, v, k_ctx, v_ctx, rel_bias):
    B, L, H, d = q.shape
    rows = L // GRID_W
    kh = min(NA_KH, rows)
    n = kh * GRID_W
    scale = 1.0 / math.sqrt(d)
    qg = q.reshape(B, rows, GRID_W, H, d)
    kg = k.reshape(B, rows, GRID_W, H, d)
    vg = v.reshape(B, rows, GRID_W, H, d)
    cq = jnp.arange(GRID_W, dtype=jnp.int32)
    c0 = jnp.clip(cq - NA_KW // 2, 0, GRID_W - NA_KW)
    col_ok = (cq[None, :] >= c0[:, None]) & (cq[None, :] < c0[:, None] + NA_KW)
    mask = jnp.tile(col_ok, (1, kh))
    dc_idx = jnp.clip(cq[None, :] - cq[:, None] + NA_KW - 1, 0, 2 * NA_KW - 2)

    def one_row(r):
        r0 = jnp.clip(r - kh // 2, 0, rows - kh)
        k_rows = lax.dynamic_slice_in_dim(kg, r0, kh, axis=1).reshape(B, n, H, d)
        v_rows = lax.dynamic_slice_in_dim(vg, r0, kh, axis=1).reshape(B, n, H, d)
        q_row = lax.dynamic_index_in_dim(qg, r, axis=1, keepdims=False)
        dr_idx = r0 + jnp.arange(kh, dtype=jnp.int32) - r + NA_KH - 1
        bias = rel_bias[:, dr_idx[None, :, None], dc_idx[:, None, :]]
        bias = bias.reshape(H, GRID_W, n).astype(jnp.float32)
        s_nb = jnp.einsum('bqhd,bjhd->bhqj', q_row, k_rows).astype(jnp.float32) * scale + bias[None]
        s_nb = jnp.where(mask[None, None], s_nb, NEG)
        s_cx = jnp.einsum('bqhd,bjhd->bhqj', q_row, k_ctx).astype(jnp.float32) * scale
        p = jax.nn.softmax(jnp.concatenate([s_nb, s_cx], axis=-1), axis=-1).astype(v.dtype)
        return (jnp.einsum('bhqj,bjhd->bqhd', p[..., :n], v_rows)
                + jnp.einsum('bhqj,bjhd->bqhd', p[..., n:], v_ctx))

    out = lax.map(one_row, jnp.arange(rows, dtype=jnp.int32))
    return out.transpose(1, 0, 2, 3, 4).reshape(B, L, H * d)


def _even_mixer(h, hc, w_in, w_out, q_g, k_g, sink, ang_row, ang_col, ctx_out):
    F = FOURIER_WIDTH
    QW = WIN_Q_HEADS * HEAD_DIM
    KW = WIN_KV_HEADS * HEAD_DIM

    def split(t):
        Bt, Lt = t.shape[0], t.shape[1]
        f = t[..., :F]
        q = _rms(t[..., F:F + QW].reshape(Bt, Lt, WIN_Q_HEADS, HEAD_DIM), q_g)
        k = _rms(t[..., F + QW:F + QW + KW].reshape(Bt, Lt, WIN_KV_HEADS, HEAD_DIM), k_g)
        v = t[..., F + QW + KW:].reshape(Bt, Lt, WIN_KV_HEADS, HEAD_DIM)
        return f, q, k, v

    f, q, k, v = split(h @ w_in)
    fc, qc, kc, vc = split(hc @ w_in)
    q = _rope_2d(q, ang_row, ang_col)
    k = _rope_2d(k, ang_row, ang_col)
    o = jnp.concatenate([_fourier_mix(f), _window_attention(q, k, v, kc, vc, sink)], axis=-1) @ w_out
    oc = None
    if ctx_out:
        oc = jnp.concatenate([_fourier_mix(fc), _ctx_attention(qc, kc, vc, sink)], axis=-1) @ w_out
    return o, oc


def _odd_mixer(h, hc, w_in, w_out, q_g, k_g, rel_bias, ctx_out):
    W = NA_HEADS * HEAD_DIM

    def split(t):
        Bt, Lt = t.shape[0], t.shape[1]
        q = _rms(t[..., :W].reshape(Bt, Lt, NA_HEADS, HEAD_DIM), q_g)
        k = _rms(t[..., W:2 * W].reshape(Bt, Lt, NA_HEADS, HEAD_DIM), k_g)
        v = t[..., 2 * W:].reshape(Bt, Lt, NA_HEADS, HEAD_DIM)
        return q, k, v

    q, k, v = split(h @ w_in)
    qc, kc, vc = split(hc @ w_in)
    o = _neighbourhood_attention(q, k, v, kc, vc, rel_bias) @ w_out
    oc = None
    if ctx_out:
        oc = _ctx_attention(qc, kc, vc, None) @ w_out
    return o, oc


def _swiglu(h, wg, wu, wd):
    return (jax.nn.silu(h @ wg) * (h @ wu)) @ wd


def setup_inputs(seed: int = 0) -> dict:
    key = jax.random.key(seed)
    ks = jax.random.split(key, 24)
    D = D_MODEL
    nrm = jax.random.normal
    f32 = jnp.float32
    return {
        "x": nrm(ks[0], (BATCH, SEQ, D), f32),
        "c": nrm(ks[1], (BATCH, D), f32),
        "ctx": nrm(ks[2], (BATCH, CTX_LEN, D), f32),
        "c_ctx": nrm(ks[3], (D,), f32),
        "ada_w": nrm(ks[4], (DEPTH, D, 6 * D), f32) * D ** -0.5,
        "ada_b": nrm(ks[5], (DEPTH, 6 * D), f32) * 0.01,
        "norm1_g": 1.0 + 0.01 * nrm(ks[6], (DEPTH, D), f32),
        "norm2_g": 1.0 + 0.01 * nrm(ks[7], (DEPTH, D), f32),
        "ffn_w_gate": nrm(ks[8], (DEPTH, D, D_FF), f32) * D ** -0.5,
        "ffn_w_up": nrm(ks[9], (DEPTH, D, D_FF), f32) * D ** -0.5,
        "ffn_w_down": nrm(ks[10], (DEPTH, D_FF, D), f32) * D_FF ** -0.5,
        "ev_w_in": nrm(ks[11], (N_EVEN, D, EV_IN_WIDTH), f32) * D ** -0.5,
        "ev_w_out": nrm(ks[12], (N_EVEN, EV_OUT_WIDTH, D), f32) * EV_OUT_WIDTH ** -0.5,
        "ev_q_norm": 1.0 + 0.01 * nrm(ks[13], (N_EVEN, HEAD_DIM), f32),
        "ev_k_norm": 1.0 + 0.01 * nrm(ks[14], (N_EVEN, HEAD_DIM), f32),
        "ev_sink": 0.5 * nrm(ks[15], (N_EVEN, WIN_Q_HEADS), f32),
        "od_w_in": nrm(ks[16], (N_ODD, D, 3 * NA_HEADS * HEAD_DIM), f32) * D ** -0.5,
        "od_w_out": nrm(ks[17], (N_ODD, NA_HEADS * HEAD_DIM, D), f32) * (NA_HEADS * HEAD_DIM) ** -0.5,
        "od_q_norm": 1.0 + 0.01 * nrm(ks[18], (N_ODD, HEAD_DIM), f32),
        "od_k_norm": 1.0 + 0.01 * nrm(ks[19], (N_ODD, HEAD_DIM), f32),
        "od_rel_bias": 0.1 * nrm(ks[20], (N_ODD, NA_HEADS, 2 * NA_KH - 1, 2 * NA_KW - 1), f32),
    }


def reference(x, c, ctx, c_ctx, ada_w, ada_b, norm1_g, norm2_g, ffn_w_gate, ffn_w_up, ffn_w_down,
              ev_w_in, ev_w_out, ev_q_norm, ev_k_norm, ev_sink,
              od_w_in, od_w_out, od_q_norm, od_k_norm, od_rel_bias):
    L = x.shape[1]
    ang_row, ang_col = _axial_angles(L)
    y = ctx
    for i in range(DEPTH):
        last = i == DEPTH - 1
        m_lat = (jax.nn.silu(c) @ ada_w[i] + ada_b[i])[:, None, :]
        m_ctx = jax.nn.silu(c_ctx) @ ada_w[i] + ada_b[i]
        sh1, sc1, g1, sh2, sc2, g2 = jnp.split(m_lat, 6, axis=-1)
        csh1, csc1, cg1, csh2, csc2, cg2 = jnp.split(m_ctx, 6, axis=-1)
        h = _rms(x, norm1_g[i]) * (1.0 + sc1) + sh1
        hc = _rms(y, norm1_g[i]) * (1.0 + csc1) + csh1
        if i % 2 == 0:
            j = i // 2
            o, oc = _even_mixer(h, hc, ev_w_in[j], ev_w_out[j], ev_q_norm[j], ev_k_norm[j],
                                ev_sink[j], ang_row, ang_col, not last)
        else:
            j = i // 2
            o, oc = _odd_mixer(h, hc, od_w_in[j], od_w_out[j], od_q_norm[j], od_k_norm[j],
                               od_rel_bias[j], not last)
        x = x + g1 * o
        h = _rms(x, norm2_g[i]) * (1.0 + sc2) + sh2
        x = x + g2 * _swiglu(h, ffn_w_gate[i], ffn_w_up[i], ffn_w_down[i])
        if not last:
            y = y + cg1 * oc
            hc = _rms(y, norm2_g[i]) * (1.0 + csc2) + csh2
            y = y + cg2 * _swiglu(hc, ffn_w_gate[i], ffn_w_up[i], ffn_w_down[i])
    return x
```

```cpp
#include <hip/hip_runtime.h>
#include <hip/hip_cooperative_groups.h>
#include <cstdio>
#include <cstdint>
namespace cg = cooperative_groups;
namespace pg8 {
#define PG8_LAS __attribute__((address_space(3)))
typedef unsigned short bf16_t;
typedef short bf16x8 __attribute__((ext_vector_type(8)));
typedef float f32x4 __attribute__((ext_vector_type(4)));
typedef unsigned u32x4 __attribute__((ext_vector_type(4)));
constexpr int BM = 256, BK = 64, HALF = 128, HTB = HALF * BK * 2  , STAGE_BYTES = 8 * HTB, NXCD = 8, WGM = 4;

__host__ __device__ __forceinline__ int lds_byte(int r, int c) { const int st = (r >> 4) * 2 + (c >> 5), rr = r & 15, cc = c & 31, ob = rr * 64 + cc * 2; return st * 1024 + (ob ^ (((ob >> 9) & 1) << 5)); }
__host__ __device__ __forceinline__ void stage_rc(int b, int& R, int& C) { const int st = b / 1024, sb = b % 1024, swz = sb ^ (((sb >> 9) & 1) << 5); R = (st >> 1) * 16 + swz / 64; C = (st & 1) * 32 + (swz % 64) / 2; }
__host__ __device__ __forceinline__ int perm32(int rho) { const int n = rho >> 4, i = rho & 15; return 8 * (i >> 2) + 4 * n + (i & 3); }

struct Unit { int pm, pn, k0, nt; };
struct Gemm { const bf16_t* A; const bf16_t* Bt; int M, N, K; };

struct StaticOrder {
    int nM, nN, nwg, G, c, ntf;
    __host__ __device__ void init(int M, int N, int G_, int c_, int K_) { nM = M / BM; nN = N / BM; nwg = nM * nN; G = G_; c = c_; ntf = K_ / BK; }
    __host__ __device__ bool next(int i, Unit& u) const {
        const long L = (long)i * G + c; if (L >= nwg) return false;
        int wgid = (int)L; { const int q = nwg / NXCD, r = nwg % NXCD, xcd = wgid % NXCD, off = wgid / NXCD; wgid = (xcd < r ? xcd * (q + 1) : r * (q + 1) + (xcd - r) * q) + off; }
        const int nig = WGM * nN, gid = wgid / nig, fm = gid * WGM, gsz = (nM - fm) < WGM ? (nM - fm) : WGM;
        u.pm = fm + ((wgid % nig) % gsz); u.pn = (wgid % nig) / gsz; u.k0 = 0; u.nt = ntf; return true;
    }
    __device__ __forceinline__ void a_ready(const Unit&) const {}
    __device__ __forceinline__ void done(const Unit&) const {}
};

struct TailSplitOrder {
    StaticOrder so; int nfull, nslices, S, nts, nMfull, nN, G, c;
    __host__ __device__ void init(int Mfull, int Mtot, int N, int G_, int c_, int K_, int S_) { so.init(Mfull, N, G_, c_, K_); nfull = so.nwg; nMfull = Mfull / BM; nN = N / BM; S = S_; nts = (K_ / BK) / S_; nslices = ((Mtot - Mfull) / BM) * nN * S_; G = G_; c = c_; }
    __host__ __device__ bool next(int i, Unit& u) const {
        const long L = (long)i * G + c; if (L < nfull) return so.next(i, u);
        const int s = (int)(L - nfull); if (s >= nslices) return false;
        const int tu = s / S, sl = s % S; u.pm = nMfull + tu / nN; u.pn = tu % nN; u.k0 = sl * nts * BK; u.nt = nts; return true;
    }
    __device__ __forceinline__ void a_ready(const Unit&) const {}
    __device__ __forceinline__ void done(const Unit&) const {}
};

__device__ __forceinline__ unsigned cvt_pk_bf16(float lo, float hi) { unsigned r; asm volatile("v_cvt_pk_bf16_f32 %0, %1, %2" : "=v"(r) : "v"(lo), "v"(hi)); return r; }
typedef float f32x2 __attribute__((ext_vector_type(2)));
typedef unsigned u32x2 __attribute__((ext_vector_type(2)));

struct EpiBf16 {
    static constexpr bool PERM = true, AFTER_DRAIN = false;
    bf16_t* O; int ldc;
    __device__ __forceinline__ void operator()(const f32x4 (&acc)[2][2][4][2], const Unit& u, int wr, int wc, int fr, int fq) const {
        const int row0 = u.pm * BM + wr * 64 + fr; const int col0 = u.pn * BM + wc * 32 + 8 * fq;
#pragma unroll
        for (int ai = 0; ai < 2; ++ai)
#pragma unroll
            for (int m = 0; m < 4; ++m) { bf16_t* rowp = O + (size_t)(row0 + ai * HALF + m * 16) * ldc + col0;
#pragma unroll
                for (int bj = 0; bj < 2; ++bj) { const f32x4 v0 = acc[ai][bj][m][0], v1 = acc[ai][bj][m][1];
                    u32x4 w; w.x = cvt_pk_bf16(v0[0], v0[1]); w.y = cvt_pk_bf16(v0[2], v0[3]); w.z = cvt_pk_bf16(v1[0], v1[1]); w.w = cvt_pk_bf16(v1[2], v1[3]);
                    *(u32x4*)(rowp + bj * HALF) = w; } }
    }
};
struct EpiResGate {
    static constexpr bool PERM = true, AFTER_DRAIN = false;
    const bf16_t* res; float* out; const float* gate;
    __device__ __forceinline__ void operator()(const f32x4 (&acc)[2][2][4][2], const Unit& u, int wr, int wc, int fr, int fq) const {
        const int rowbase = u.pm * BM; const int bidx = rowbase >> 12;
        const bf16_t* rs = res + (size_t)rowbase * 1024; float* o = out + (size_t)rowbase * 1024;
        const int col0 = u.pn * BM + wc * 32 + 8 * fq;
        f32x4 gv[2][2];
#pragma unroll
        for (int bj = 0; bj < 2; ++bj)
#pragma unroll
            for (int n = 0; n < 2; ++n) gv[bj][n] = *(const f32x4*)(gate + (size_t)bidx * 6144 + col0 + bj * HALF + 4 * n);
#pragma unroll
        for (int am = 0; am < 8; am += 4) { const int ai = am >> 2; u32x4 rbh[4][2];
#pragma unroll
            for (int mm = 0; mm < 4; ++mm) { const size_t off = (size_t)(ai * HALF + wr * 64 + ((am & 3) + mm) * 16 + fr) * 1024 + col0;
#pragma unroll
                for (int bj = 0; bj < 2; ++bj) rbh[mm][bj] = *(const u32x4*)(rs + off + bj * HALF); }
#pragma unroll
            for (int mm = 0; mm < 4; ++mm) { const int m = (am & 3) + mm; const size_t off = (size_t)(ai * HALF + wr * 64 + m * 16 + fr) * 1024 + col0;
#pragma unroll
                for (int bj = 0; bj < 2; ++bj) { const u32x4 rb = rbh[mm][bj];
                    const f32x4 b0 = {__uint_as_float(rb.x << 16), __uint_as_float(rb.x & 0xffff0000u), __uint_as_float(rb.y << 16), __uint_as_float(rb.y & 0xffff0000u)};
                    const f32x4 b1 = {__uint_as_float(rb.z << 16), __uint_as_float(rb.z & 0xffff0000u), __uint_as_float(rb.w << 16), __uint_as_float(rb.w & 0xffff0000u)};
                    *(f32x4*)(o + off + bj * HALF) = b0 + gv[bj][0] * acc[ai][bj][m][0];
                    *(f32x4*)(o + off + bj * HALF + 4) = b1 + gv[bj][1] * acc[ai][bj][m][1]; } } }
    }
};
template <bool RES_F32> struct EpiResGateN {
    static constexpr bool PERM = true, AFTER_DRAIN = false;
    const void* res_lat; const void* res_ctx; bf16_t* out_lat; bf16_t* out_ctx; const float* gate; const float* gam; bf16_t* XNo; float* rss; float* part; int ntfull;
    __device__ __forceinline__ void operator()(const f32x4 (&acc)[2][2][4][2], const Unit& u, int wr, int wc, int fr_in, int fq_in) const {
        int fr = fr_in, fq = fq_in; asm volatile("" : "+v"(fr), "+v"(fq));
        if (u.nt != ntfull) {
            const int sl = u.k0 / (u.nt * BK); float* pp = part + ((size_t)sl * 1024 + (size_t)(u.pm - 64) * BM) * 1024 + u.pn * BM + wc * 32 + 8 * fq;
#pragma unroll
            for (int ai = 0; ai < 2; ++ai)
#pragma unroll
                for (int m = 0; m < 4; ++m) { const size_t off = (size_t)(ai * HALF + wr * 64 + m * 16 + fr) * 1024;
#pragma unroll
                    for (int bj = 0; bj < 2; ++bj)
#pragma unroll
                        for (int n = 0; n < 2; ++n) *(f32x4*)(pp + off + bj * HALF + 4 * n) = acc[ai][bj][m][n]; }
            return;
        }
        const int rowbase = u.pm * BM; const bool isctx = rowbase >= 16384; const int bidx = isctx ? 4 : (rowbase >> 12);
        const size_t rb_ = isctx ? (size_t)(rowbase - 16384) * 1024 : (size_t)rowbase * 1024;
        const float* resf = (const float*)(isctx ? res_ctx : res_lat) + rb_; const bf16_t* resh = (const bf16_t*)(isctx ? res_ctx : res_lat) + rb_;
        bf16_t* out = (isctx ? out_ctx : out_lat) + rb_;
        bf16_t* xn = XNo + (size_t)rowbase * 1024; float* rs = rss + rowbase;
        const int col0 = u.pn * BM + wc * 32 + 8 * fq;
        f32x4 gv[2][2], gm[2][2];
#pragma unroll
        for (int bj = 0; bj < 2; ++bj)
#pragma unroll
            for (int n = 0; n < 2; ++n) { gv[bj][n] = *(const f32x4*)(gate + (size_t)bidx * 6144 + col0 + bj * HALF + 4 * n); gm[bj][n] = *(const f32x4*)(gam + (size_t)bidx * 1024 + col0 + bj * HALF + 4 * n); }
#pragma unroll
        for (int ai = 0; ai < 2; ++ai) {
            constexpr int MG = RES_F32 ? 2 : 4;
#pragma unroll
            for (int mb = 0; mb < 4; mb += MG) {
                u32x4 rbh[MG][2]; f32x4 rbf[MG][2][2];
#pragma unroll
                for (int mm = 0; mm < MG; ++mm) { const size_t off = (size_t)(ai * HALF + wr * 64 + (mb + mm) * 16 + fr) * 1024 + col0;
#pragma unroll
                    for (int bj = 0; bj < 2; ++bj) { if (RES_F32) { rbf[mm][bj][0] = *(const f32x4*)(resf + off + bj * HALF); rbf[mm][bj][1] = *(const f32x4*)(resf + off + bj * HALF + 4); } else rbh[mm][bj] = *(const u32x4*)(resh + off + bj * HALF); } }
#pragma unroll
                for (int mm = 0; mm < MG; ++mm) { const int m = mb + mm; const int r = ai * HALF + wr * 64 + m * 16 + fr; const size_t off = (size_t)r * 1024 + col0; float ss = 0.f;
#pragma unroll
                    for (int bj = 0; bj < 2; ++bj) { f32x4 b0, b1;
                        if (RES_F32) { b0 = rbf[mm][bj][0]; b1 = rbf[mm][bj][1]; }
                        else { const u32x4 rb = rbh[mm][bj];
                            b0 = (f32x4){__uint_as_float(rb.x << 16), __uint_as_float(rb.x & 0xffff0000u), __uint_as_float(rb.y << 16), __uint_as_float(rb.y & 0xffff0000u)};
                            b1 = (f32x4){__uint_as_float(rb.z << 16), __uint_as_float(rb.z & 0xffff0000u), __uint_as_float(rb.w << 16), __uint_as_float(rb.w & 0xffff0000u)}; }
                        const f32x4 o0 = b0 + gv[bj][0] * acc[ai][bj][m][0], o1 = b1 + gv[bj][1] * acc[ai][bj][m][1];
                        { u32x4 wo; wo.x = cvt_pk_bf16(o0[0], o0[1]); wo.y = cvt_pk_bf16(o0[2], o0[3]); wo.z = cvt_pk_bf16(o1[0], o1[1]); wo.w = cvt_pk_bf16(o1[2], o1[3]); *(u32x4*)(out + off + bj * HALF) = wo; }
                        ss += ((o0[0] * o0[0] + o0[1] * o0[1]) + (o0[2] * o0[2] + o0[3] * o0[3])) + ((o1[0] * o1[0] + o1[1] * o1[1]) + (o1[2] * o1[2] + o1[3] * o1[3]));
                        const f32x4 y0 = o0 * gm[bj][0], y1 = o1 * gm[bj][1];
                        { u32x4 w; w.x = cvt_pk_bf16(y0[0], y0[1]); w.y = cvt_pk_bf16(y0[2], y0[3]); w.z = cvt_pk_bf16(y1[0], y1[1]); w.w = cvt_pk_bf16(y1[2], y1[3]); *(u32x4*)(xn + off + bj * HALF) = w; } }
                    ss += __int_as_float(__builtin_amdgcn_ds_swizzle(__float_as_int(ss), (16 << 10) | 0x1F));
                    ss += __int_as_float(__builtin_amdgcn_ds_bpermute((((fq * 16 + fr) ^ 32) << 2), __float_as_int(ss)));
                    if (fq == 0) __hip_atomic_fetch_add(rs + r, ss, __ATOMIC_RELAXED, __HIP_MEMORY_SCOPE_AGENT); }
            }
        }
    }
};
struct EpiBf16N {
    static constexpr bool PERM = true, AFTER_DRAIN = false;
    bf16_t* O; int ldc; const float* rss; const float* bias;
    __device__ __forceinline__ void operator()(const f32x4 (&acc)[2][2][4][2], const Unit& u, int wr, int wc, int fr, int fq) const {
        const int rowbase = u.pm * BM; const int bidx = rowbase >= 16384 ? 4 : (rowbase >> 12);
        const int row0 = rowbase + wr * 64 + fr; const int col0 = u.pn * BM + wc * 32 + 8 * fq;
        f32x4 bv[2][2];
#pragma unroll
        for (int bj = 0; bj < 2; ++bj)
#pragma unroll
            for (int n = 0; n < 2; ++n) bv[bj][n] = *(const f32x4*)(bias + (size_t)bidx * ldc + col0 + bj * HALF + 4 * n);
        float rstd8[2][4];
#pragma unroll
        for (int ai = 0; ai < 2; ++ai)
#pragma unroll
            for (int m = 0; m < 4; ++m) rstd8[ai][m] = __builtin_amdgcn_rsqf(rss[row0 + ai * HALF + m * 16] * (1.0f / 1024.0f) + 1e-6f);
#pragma unroll
        for (int ai = 0; ai < 2; ++ai)
#pragma unroll
            for (int m = 0; m < 4; ++m) { const int row = row0 + ai * HALF + m * 16; const float rstd = rstd8[ai][m];
                bf16_t* rowp = O + (size_t)row * ldc + col0;
#pragma unroll
                for (int bj = 0; bj < 2; ++bj) { const f32x4 v0 = acc[ai][bj][m][0] * rstd + bv[bj][0], v1 = acc[ai][bj][m][1] * rstd + bv[bj][1];
                    u32x4 w; w.x = cvt_pk_bf16(v0[0], v0[1]); w.y = cvt_pk_bf16(v0[2], v0[3]); w.z = cvt_pk_bf16(v1[0], v1[1]); w.w = cvt_pk_bf16(v1[2], v1[3]);
                    *(u32x4*)(rowp + bj * HALF) = w; } }
    }
};
struct EpiSwiGLUN {
    static constexpr bool PERM = true, AFTER_DRAIN = false;
    bf16_t* Hh; const float* rss; const float* bias;
    __device__ __forceinline__ void operator()(const f32x4 (&acc)[2][2][4][2], const Unit& u, int wr, int wc, int fr, int fq) const {
        const int rowbase = u.pm * BM; const int bidx = rowbase >= 16384 ? 4 : (rowbase >> 12);
        const int row0 = rowbase + wr * 64 + fr; const int f0 = u.pn * 128 + wc * 32 + 8 * fq; const int c0 = u.pn * BM + wc * 32 + 8 * fq;
        f32x4 bg[2], bu[2];
#pragma unroll
        for (int bj = 0; bj < 2; ++bj) { bg[bj] = *(const f32x4*)(bias + (size_t)bidx * 5632 + c0 + bj * HALF); bu[bj] = *(const f32x4*)(bias + (size_t)bidx * 5632 + c0 + bj * HALF + 4); }
        float rstd8[2][4];
#pragma unroll
        for (int ai = 0; ai < 2; ++ai)
#pragma unroll
            for (int m = 0; m < 4; ++m) rstd8[ai][m] = __builtin_amdgcn_rsqf(rss[row0 + ai * HALF + m * 16] * (1.0f / 1024.0f) + 1e-6f);
#pragma unroll
        for (int ai = 0; ai < 2; ++ai)
#pragma unroll
            for (int m = 0; m < 4; ++m) { const int row = row0 + ai * HALF + m * 16; const float rstd = rstd8[ai][m];
                f32x4 o[2];
#pragma unroll
                for (int bj = 0; bj < 2; ++bj) { const f32x4 g = acc[ai][bj][m][0] * rstd + bg[bj], up = acc[ai][bj][m][1] * rstd + bu[bj];
#pragma unroll
                    for (int j = 0; j < 4; ++j) { const float e = __builtin_amdgcn_exp2f(-1.4426950408889634f * g[j]); o[bj][j] = g[j] * __builtin_amdgcn_rcpf(1.0f + e) * up[j]; } }
                u32x4 w; w.x = cvt_pk_bf16(o[0][0], o[0][1]); w.y = cvt_pk_bf16(o[0][2], o[0][3]); w.z = cvt_pk_bf16(o[1][0], o[1][1]); w.w = cvt_pk_bf16(o[1][2], o[1][3]);
                *(u32x4*)(Hh + (size_t)row * 2816 + f0) = w; }
    }
};
struct EpiSwiGLU {
    static constexpr bool PERM = false, AFTER_DRAIN = false;
    bf16_t* Hh;
    __device__ __forceinline__ void operator()(const f32x4 (&acc)[2][2][4][2], const Unit& u, int wr, int wc, int fr, int fq) const {
        const int row0 = u.pm * BM + wr * 64 + fr; const int f0 = u.pn * 128 + wc * 16 + 4 * fq;
#pragma unroll
        for (int ai = 0; ai < 2; ++ai)
#pragma unroll
            for (int m = 0; m < 4; ++m) { bf16_t* rowp = Hh + (size_t)(row0 + ai * HALF + m * 16) * 2816 + f0;
#pragma unroll
                for (int bj = 0; bj < 2; ++bj) { const f32x4 g = acc[ai][bj][m][0], up = acc[ai][bj][m][1]; f32x4 o;
#pragma unroll
                    for (int j = 0; j < 4; ++j) { const float e = __builtin_amdgcn_exp2f(-1.4426950408889634f * g[j]); o[j] = g[j] * __builtin_amdgcn_rcpf(1.0f + e) * up[j]; }
                    u32x2 w; w.x = cvt_pk_bf16(o[0], o[1]); w.y = cvt_pk_bf16(o[2], o[3]);
                    *(u32x2*)(rowp + bj * 64) = w; } }
    }
};
template <class Epi, class Sched, bool ALIGN_EPI = false, bool SP2 = false>
__device__ __forceinline__ void gemm_phase(PG8_LAS unsigned char* lds, const Gemm g, const Sched& S, const Epi& E, const int wave_s) {
    int z_ = 0; asm volatile("" : "+s"(z_)); const int lane = __builtin_amdgcn_mbcnt_hi(~0u, __builtin_amdgcn_mbcnt_lo(~0u, z_)), wid = wave_s, tid = wid * 64 + lane, wr = wid >> 2, wc = wid & 3, fr = lane & 15, fq = lane >> 4;
    const int K = g.K;
    unsigned voffA[2], voffB[2];
#pragma unroll
    for (int i = 0; i < 2; ++i) { int R, C; stage_rc(tid * 16 + i * 8192, R, C); const int Rb = Epi::PERM ? ((R & ~31) + perm32(R & 31)) : R;
        voffA[i] = (unsigned)(R * K + C) * 2u; voffB[i] = (unsigned)(Rb * K + C) * 2u; }
    const size_t kstep = (size_t)(BK * 2);
    const size_t hstep = (size_t)HALF * K * 2;
    const size_t tstep = 2 * hstep;
    const unsigned ldsw = (unsigned)wid * 1024u;
    const int aoff = lds_byte(wr * 64 + fr, fq * 8), boff = lds_byte(wc * 32 + fr, fq * 8);
#define PG8_SA(b, h) (((b) * 2 + (h)) * HTB)
#define PG8_SB(b, h) ((4 + (b) * 2 + (h)) * HTB)
#define PG8_STAGE(bufoff, gbase, voff) do { _Pragma("unroll") for (int _i = 0; _i < 2; ++_i) \
        __builtin_amdgcn_global_load_lds((const unsigned*)((const char*)(gbase) + (voff)[_i]), (PG8_LAS unsigned*)(lds + (bufoff) + ldsw + _i * 8192), 16, 0, 0); } while (0)
#define PG8_LDA(dst, b, h) do { _Pragma("unroll") for (int m = 0; m < 4; ++m) _Pragma("unroll") for (int k = 0; k < 2; ++k) dst[m][k] = *(const PG8_LAS bf16x8*)(lds + PG8_SA(b, h) + aoff + m * 2048 + k * 1024); } while (0)
#define PG8_LDB(dst, b, h) do { _Pragma("unroll") for (int n = 0; n < 2; ++n) _Pragma("unroll") for (int k = 0; k < 2; ++k) dst[n][k] = *(const PG8_LAS bf16x8*)(lds + PG8_SB(b, h) + boff + n * 2048 + k * 1024); } while (0)
#define PG8_MMA(ai, bj, At, Bt) do { __builtin_amdgcn_s_setprio(1); _Pragma("unroll") for (int m = 0; m < 4; ++m) _Pragma("unroll") for (int n = 0; n < 2; ++n) _Pragma("unroll") for (int k = 0; k < 2; ++k) \
        acc[ai][bj][m][n] = __builtin_amdgcn_mfma_f32_16x16x32_bf16(Bt[n][k], At[m][k], acc[ai][bj][m][n], 0, 0, 0); __builtin_amdgcn_s_setprio(0); } while (0)
#define PG8_WAIT_V(n) asm volatile("s_waitcnt vmcnt(" #n ")" ::: "memory")
#define PG8_WAIT_L(n) asm volatile("s_waitcnt lgkmcnt(" #n ")" ::: "memory")
#define PG8_BAR __builtin_amdgcn_s_barrier()
#define PG8_SCHED __builtin_amdgcn_sched_barrier(0)
    Unit cur, nxt; int ui = 0;
    if (!S.next(0, cur)) return;
    int nt = cur.nt;
    f32x4 acc[2][2][4][2];
#pragma unroll
    for (int a = 0; a < 2; ++a)
#pragma unroll
        for (int b = 0; b < 2; ++b)
#pragma unroll
            for (int m = 0; m < 4; ++m)
#pragma unroll
                for (int n = 0; n < 2; ++n) acc[a][b][m][n] = (f32x4){0.f, 0.f, 0.f, 0.f};
    bf16x8 At[4][2], B0[2][2], B1[2][2];
    const char* cA = (const char*)g.A + (size_t)cur.pm * tstep + (size_t)cur.k0 * 2; const char* cB = (const char*)g.Bt + (size_t)cur.pn * tstep + (size_t)cur.k0 * 2;
    S.a_ready(cur);
    if constexpr (SP2) {
        PG8_STAGE(PG8_SB(0, 0), cB, voffB); PG8_STAGE(PG8_SB(0, 1), cB + hstep, voffB); PG8_STAGE(PG8_SA(0, 0), cA, voffA); PG8_STAGE(PG8_SA(0, 1), cA + hstep, voffA);
        if (wr == 1) PG8_BAR;
        PG8_WAIT_V(2); PG8_BAR;
        PG8_STAGE(PG8_SB(1, 0), cB + kstep, voffB); PG8_STAGE(PG8_SA(1, 0), cA + kstep, voffA); PG8_STAGE(PG8_SB(1, 1), cB + hstep + kstep, voffB);
        PG8_WAIT_V(6); PG8_BAR;
    } else {
        PG8_STAGE(PG8_SB(0, 0), cB, voffB); PG8_STAGE(PG8_SA(0, 0), cA, voffA); PG8_STAGE(PG8_SB(0, 1), cB + hstep, voffB); PG8_STAGE(PG8_SA(0, 1), cA + hstep, voffA);
        if (wr == 1) PG8_BAR;
        PG8_WAIT_V(4); PG8_BAR;
        PG8_STAGE(PG8_SB(1, 0), cB + kstep, voffB); PG8_STAGE(PG8_SA(1, 0), cA + kstep, voffA); PG8_STAGE(PG8_SB(1, 1), cB + hstep + kstep, voffB);
        PG8_WAIT_V(6); PG8_BAR;
    }
    for (;;) {
        const bool has_next = S.next(ui + 1, nxt);
        const char* nA = has_next ? (const char*)g.A + (size_t)nxt.pm * tstep + (size_t)nxt.k0 * 2 : cA; const char* nB = has_next ? (const char*)g.Bt + (size_t)nxt.pn * tstep + (size_t)nxt.k0 * 2 : cB;
        for (int t = 0; t < nt; t += 2) {
            const bool last = (t == nt - 2);
            const char* a1 = cA + (size_t)(t + 1) * kstep;
            const char* a2 = last ? nA : cA + (size_t)(t + 2) * kstep; const char* b2 = last ? nB : cB + (size_t)(t + 2) * kstep;
            const char* a3 = a2 + kstep; const char* b3 = b2 + kstep;
            if (last && has_next) S.a_ready(nxt);
            if constexpr (SP2) {
            PG8_LDB(B0, 0, 0); PG8_LDB(B1, 0, 1); PG8_SCHED; PG8_LDA(At, 0, 0); PG8_STAGE(PG8_SA(1, 1), a1 + hstep, voffA);
            PG8_WAIT_V(8); PG8_WAIT_L(0); PG8_BAR; PG8_MMA(0, 0, At, B0); PG8_MMA(0, 1, At, B1); PG8_BAR; PG8_SCHED;
            PG8_LDA(At, 0, 1); PG8_STAGE(PG8_SB(0, 0), b2, voffB); PG8_STAGE(PG8_SB(0, 1), b2 + hstep, voffB); PG8_STAGE(PG8_SA(0, 0), a2, voffA);
            PG8_WAIT_V(8); PG8_WAIT_L(0); PG8_BAR; PG8_MMA(1, 0, At, B0); PG8_MMA(1, 1, At, B1); PG8_BAR; PG8_SCHED;
            PG8_LDB(B0, 1, 0); PG8_LDB(B1, 1, 1); PG8_SCHED; PG8_LDA(At, 1, 0); PG8_STAGE(PG8_SA(0, 1), a2 + hstep, voffA);
            PG8_WAIT_V(8); PG8_WAIT_L(0); PG8_BAR; PG8_MMA(0, 0, At, B0); PG8_MMA(0, 1, At, B1); PG8_BAR; PG8_SCHED;
            PG8_LDA(At, 1, 1); PG8_STAGE(PG8_SB(1, 0), b3, voffB); PG8_STAGE(PG8_SB(1, 1), b3 + hstep, voffB); PG8_STAGE(PG8_SA(1, 0), a3, voffA);
            PG8_WAIT_V(8); PG8_WAIT_L(0); PG8_BAR; PG8_MMA(1, 0, At, B0); PG8_MMA(1, 1, At, B1); PG8_BAR; PG8_SCHED;
            } else {
            PG8_LDB(B0, 0, 0); PG8_SCHED; PG8_LDA(At, 0, 0); PG8_STAGE(PG8_SA(1, 1), a1 + hstep, voffA);
            PG8_WAIT_L(8); PG8_BAR; PG8_WAIT_L(0); PG8_MMA(0, 0, At, B0); PG8_BAR; PG8_SCHED;
            PG8_LDB(B1, 0, 1); PG8_STAGE(PG8_SB(0, 0), b2, voffB);
            PG8_BAR; PG8_WAIT_L(0); PG8_MMA(0, 1, At, B1); PG8_BAR;
            PG8_LDA(At, 0, 1); PG8_STAGE(PG8_SA(0, 0), a2, voffA);
            PG8_BAR; PG8_WAIT_L(0); PG8_MMA(1, 0, At, B0); PG8_BAR; PG8_SCHED;
            PG8_STAGE(PG8_SB(0, 1), b2 + hstep, voffB);
            PG8_WAIT_V(6); PG8_BAR; PG8_MMA(1, 1, At, B1); PG8_BAR;
            PG8_LDB(B0, 1, 0); PG8_SCHED; PG8_LDA(At, 1, 0); PG8_STAGE(PG8_SA(0, 1), a2 + hstep, voffA);
            PG8_WAIT_L(8); PG8_BAR; PG8_WAIT_L(0); PG8_MMA(0, 0, At, B0); PG8_BAR; PG8_SCHED;
            PG8_LDB(B1, 1, 1); PG8_STAGE(PG8_SB(1, 0), b3, voffB);
            PG8_BAR; PG8_WAIT_L(0); PG8_MMA(0, 1, At, B1); PG8_BAR;
            PG8_LDA(At, 1, 1); PG8_STAGE(PG8_SA(1, 0), a3, voffA);
            PG8_BAR; PG8_WAIT_L(0); PG8_MMA(1, 0, At, B0); PG8_BAR; PG8_SCHED;
            PG8_STAGE(PG8_SB(1, 1), b3 + hstep, voffB);
            PG8_WAIT_V(6); PG8_BAR; PG8_MMA(1, 1, At, B1); PG8_BAR;
            }
        }
        if constexpr (ALIGN_EPI) { if (wr == 0) PG8_BAR; }
        if constexpr (!Epi::AFTER_DRAIN) { E(acc, cur, wr, wc, fr, fq); S.done(cur); }
        if (!has_next) break;
#pragma unroll
        for (int a = 0; a < 2; ++a)
#pragma unroll
            for (int b = 0; b < 2; ++b)
#pragma unroll
                for (int m = 0; m < 4; ++m)
#pragma unroll
                    for (int n = 0; n < 2; ++n) acc[a][b][m][n] = (f32x4){0.f, 0.f, 0.f, 0.f};
        cur = nxt; cA = nA; cB = nB; nt = cur.nt; ++ui;
        if constexpr (ALIGN_EPI) { if (wr == 1) PG8_BAR; }
    }
    PG8_WAIT_V(0);
    if constexpr (!ALIGN_EPI) { if (wr == 0) PG8_BAR; }
    PG8_BAR;
    if constexpr (Epi::AFTER_DRAIN) { E.fused(acc, cur, wr, wc, fr, fq, lds, wid, lane); S.done(cur); }
#undef PG8_SA
#undef PG8_SB
#undef PG8_STAGE
#undef PG8_LDA
#undef PG8_LDB
#undef PG8_MMA
#undef PG8_WAIT_V
#undef PG8_WAIT_L
#undef PG8_BAR
#undef PG8_SCHED
}
}

#define LAS __attribute__((address_space(3)))
typedef unsigned short bf16_t;
typedef short bf16x8 __attribute__((ext_vector_type(8)));
typedef short bf16x4 __attribute__((ext_vector_type(4)));
typedef float f32x4 __attribute__((ext_vector_type(4)));
typedef float f32x2 __attribute__((ext_vector_type(2)));
typedef float f32x16 __attribute__((ext_vector_type(16)));
typedef unsigned u32x4 __attribute__((ext_vector_type(4)));
typedef unsigned u32x2 __attribute__((ext_vector_type(2)));

constexpr int DM = 1024, NB = 4, SEQ = 4096, CTXL = 256, ML = NB * SEQ, MC = NB * CTXL, MT = ML + MC;
constexpr int DFF = 2816, NGU = 2 * DFF, EVIN = 1280, ODIN = 3072, KOUT0 = 1536;
constexpr int NWAVES = 8, NTHR = 512;
constexpr size_t MiB = 1u << 20;
constexpr size_t WS_MOD = 65536, WS_ROPE = 320 * 1024, WS_GAM = 384 * 1024, WS_RSS = 448 * 1024, WS_BIAS = 704 * 1024;
constexpr size_t WS_WIN0 = 1 * MiB, WS_WOUT0 = WS_WIN0 + (size_t)EVIN * DM * 2, WS_WGU0 = WS_WOUT0 + (size_t)DM * KOUT0 * 2, WS_WD0 = WS_WGU0 + (size_t)NGU * DM * 2;
constexpr size_t WS_WIN1 = WS_WD0 + (size_t)DM * DFF * 2, WS_WOUT1 = WS_WIN1 + (size_t)ODIN * DM * 2, WS_WGU1 = WS_WOUT1 + (size_t)DM * DM * 2, WS_WD1 = WS_WGU1 + (size_t)NGU * DM * 2;
constexpr size_t WS_WEND = WS_WD1 + (size_t)DM * DFF * 2;
constexpr size_t WS_XS = 48 * MiB, WS_XN = 116 * MiB, WS_BIG = 150 * MiB, WS_END = 252 * MiB;
constexpr size_t WS_T0 = WS_BIG, WS_A20 = WS_BIG + 43 * MiB;
static_assert(WS_WEND <= WS_XS, "weights");
static_assert(WS_XS + (size_t)MT * DM * 4 <= WS_XN && WS_XN + (size_t)MT * DM * 2 <= WS_BIG, "ws map");
static_assert(WS_T0 + (size_t)MT * EVIN * 2 <= WS_A20 && WS_A20 + (size_t)MT * KOUT0 * 2 <= WS_END && WS_BIG + (size_t)MT * ODIN * 2 <= WS_END && WS_BIG + (size_t)MT * DFF * 2 <= WS_END, "big region");
constexpr int LDS_BYTES = 155648;

struct Params {
    const float *x, *c, *ctx, *c_ctx, *ada_w, *ada_b, *norm1_g, *norm2_g, *w_gate, *w_up, *w_down, *ev_w_in, *ev_w_out, *ev_qn, *ev_kn, *ev_sink, *od_w_in, *od_w_out, *od_qn, *od_kn, *od_rb;
    float* out; unsigned char* ws;
};

__device__ __forceinline__ unsigned pk2(float lo, float hi) { typedef __bf16 bfx2 __attribute__((ext_vector_type(2))); f32x2 v = {lo, hi}; bfx2 b = __builtin_convertvector(v, bfx2); return __builtin_bit_cast(unsigned, b); }
__device__ __forceinline__ float bflo(unsigned w) { return __uint_as_float(w << 16); }
__device__ __forceinline__ float bfhi(unsigned w) { return __uint_as_float(w & 0xffff0000u); }
template <int K> __device__ __forceinline__ float swz_xor(float v) { return __int_as_float(__builtin_amdgcn_ds_swizzle(__float_as_int(v), (K << 10) | 0x1F)); }
__device__ __forceinline__ float xor32(float v, int lane) { return __int_as_float(__builtin_amdgcn_ds_bpermute((lane ^ 32) << 2, __float_as_int(v))); }
__device__ __forceinline__ float wave_sum(float v, int lane) {
    v += swz_xor<1>(v); v += swz_xor<2>(v); v += swz_xor<4>(v); v += swz_xor<8>(v); v += swz_xor<16>(v); v += xor32(v, lane);
    return v;
}
__device__ __forceinline__ float cos_rev(float r) { return __builtin_amdgcn_cosf(r); }
__device__ __forceinline__ float sin_rev(float r) { return __builtin_amdgcn_sinf(r); }

__device__ __forceinline__ int gu_row(int F, int isup) { return (F >> 7) * 256 + ((F >> 2) & 1) * 128 + ((F >> 5) & 3) * 32 + ((F >> 3) & 3) * 8 + isup * 4 + (F & 3); }
struct TDesc { const float* W; int N; bf16_t* WT; int ldk, koff, mode, item; };
__device__ __forceinline__ void tr_load(const TDesc& d, f32x4 (&v)[8], int tid) {
    const int nblk = d.N / 128, kb = d.item / nblk, nb = d.item % nblk, k0 = 128 * kb, n0 = 128 * nb; const int r = tid >> 5, c4 = tid & 31;
#pragma unroll
    for (int p = 0; p < 8; ++p) v[p] = *(const f32x4*)(d.W + (size_t)(k0 + r + 16 * p) * d.N + n0 + 4 * c4);
}
__device__ __forceinline__ void tr_stage(const f32x4 (&v)[8], LAS float* tile, int tid) {
    const int r = tid >> 5, c4 = tid & 31;
#pragma unroll
    for (int p = 0; p < 8; ++p) { LAS float* dd = tile + (r + 16 * p) * 129 + 4 * c4; dd[0] = v[p].x; dd[1] = v[p].y; dd[2] = v[p].z; dd[3] = v[p].w; }
}
__device__ __forceinline__ void tr_store(const TDesc& d, const LAS float* tile, int tid) {
    const int nblk = d.N / 128, kb = d.item / nblk, nb = d.item % nblk, k0 = 128 * kb, n0 = 128 * nb; const int c = tid & 7, nl = tid >> 3;
#pragma unroll
    for (int p = 0; p < 4; ++p) { const int n = nl + 64 * (p & 1), q = c + 8 * (p >> 1); const LAS float* s = tile + (8 * q) * 129 + n;
        u32x4 o; o.x = pk2(s[0 * 129], s[1 * 129]); o.y = pk2(s[2 * 129], s[3 * 129]); o.z = pk2(s[4 * 129], s[5 * 129]); o.w = pk2(s[6 * 129], s[7 * 129]);
        const int nn = n0 + n; const int row = d.mode == 0 ? nn : gu_row(nn, d.mode - 1);
        *(u32x4*)(d.WT + (size_t)row * d.ldk + d.koff + k0 + 8 * q) = o; }
}
__device__ __forceinline__ TDesc tdesc0(int r, const float* ev_in, const float* ev_out, const float* wg, const float* wu, const float* wd, unsigned char* ws) {
    constexpr int I_IN0 = 8 * (EVIN / 128), I_OUT0 = 4 * 8, I_G = 8 * (DFF / 128);
    if (r < I_IN0) return TDesc{ev_in, EVIN, (bf16_t*)(ws + WS_WIN0), DM, 0, 0, r}; r -= I_IN0;
    if (r < I_OUT0) return TDesc{ev_out + (size_t)512 * DM, DM, (bf16_t*)(ws + WS_WOUT0), KOUT0, 1024, 0, r}; r -= I_OUT0;
    if (r < I_G) return TDesc{wg, DFF, (bf16_t*)(ws + WS_WGU0), DM, 0, 1, r}; r -= I_G;
    if (r < I_G) return TDesc{wu, DFF, (bf16_t*)(ws + WS_WGU0), DM, 0, 2, r}; r -= I_G;
    return TDesc{wd, DM, (bf16_t*)(ws + WS_WD0), DFF, 0, 0, r};
}
__device__ __forceinline__ TDesc tdesc1(int r, const float* od_in, const float* od_out, const float* wg, const float* wu, const float* wd, unsigned char* ws) {
    constexpr int I_IN1 = 8 * (ODIN / 128), I_OUT1 = 8 * 8, I_G = 8 * (DFF / 128);
    if (r < I_IN1) return TDesc{od_in, ODIN, (bf16_t*)(ws + WS_WIN1), DM, 0, 0, r}; r -= I_IN1;
    if (r < I_OUT1) return TDesc{od_out, DM, (bf16_t*)(ws + WS_WOUT1), DM, 0, 0, r}; r -= I_OUT1;
    if (r < I_G) return TDesc{wg + (size_t)DM * DFF, DFF, (bf16_t*)(ws + WS_WGU1), DM, 0, 1, r}; r -= I_G;
    if (r < I_G) return TDesc{wu + (size_t)DM * DFF, DFF, (bf16_t*)(ws + WS_WGU1), DM, 0, 2, r}; r -= I_G;
    return TDesc{wd + (size_t)DFF * DM, DM, (bf16_t*)(ws + WS_WD1), DFF, 0, 0, r};
}
__device__ __forceinline__ void fourier_w_item(LAS unsigned char* lds, const float* w_out, bf16_t* WOUT0, int item, int tid) {
    const int g = item >> 6, n0 = (item & 63) * 16;
    LAS float* w = (LAS float*)lds; LAS f32x2* tab = (LAS f32x2*)(lds + 8192);
    for (int i = tid; i < 128 * 16; i += NTHR) w[i] = w_out[(size_t)(g * 128 + (i >> 4)) * 1024 + n0 + (i & 15)];
    if (tid < 128) { const float r = (float)tid * (1.0f / 128.0f); tab[tid] = (f32x2){cos_rev(r), sin_rev(r)}; }
    __syncthreads();
    const int nl = tid & 15, cg4 = (tid >> 4) * 4;
    float aC[4] = {0.f, 0.f, 0.f, 0.f}, aS[4] = {0.f, 0.f, 0.f, 0.f};
#pragma unroll 4
    for (int m = 0; m < 128; ++m) { const float xv = w[m * 16 + nl];
#pragma unroll
        for (int ci = 0; ci < 4; ++ci) { const f32x2 cs = tab[((cg4 + ci) * m) & 127]; aC[ci] += cs.x * xv; aS[ci] += cs.y * xv; } }
    const float s = 0.08838834764831845f;
    bf16_t* dst = WOUT0 + (size_t)(n0 + nl) * KOUT0 + g * 128 + cg4;
    u32x2 o; o.x = pk2(aC[0] * s, aC[1] * s); o.y = pk2(aC[2] * s, aC[3] * s); *(u32x2*)dst = o;
    o.x = pk2(aS[0] * s, aS[1] * s); o.y = pk2(aS[2] * s, aS[3] * s); *(u32x2*)(dst + 512) = o;
    __syncthreads();
}
__device__ __forceinline__ void adaln_unit(LAS unsigned char* lds, const float* c, const float* c_ctx, const float* ada_w, const float* ada_b, float* mod, int unit, int tid) {
    const int layer = unit / 48, n0 = (unit % 48) * 128;
    LAS float* sv = (LAS float*)lds; LAS f32x4* red = (LAS f32x4*)(lds + 20480);
#pragma unroll
    for (int hb = 0; hb < 2; ++hb) { float xin[5];
#pragma unroll
      for (int q = 0; q < 5; ++q) { const int i = tid + (5 * hb + q) * NTHR, v = __builtin_amdgcn_readfirstlane(i >> 10), k = i & 1023; const float* src = v < 4 ? c + v * 1024 : c_ctx; xin[q] = src[k]; }
#pragma unroll
      for (int q = 0; q < 5; ++q) { const float xv = xin[q]; sv[tid + (5 * hb + q) * NTHR] = xv * __builtin_amdgcn_rcpf(1.0f + __builtin_amdgcn_exp2f(-1.4426950408889634f * xv)); } }
    __syncthreads();
    const int cg = tid & 31, kc = tid >> 5;
    f32x4 acc[5];
#pragma unroll
    for (int v = 0; v < 5; ++v) acc[v] = (f32x4){0.f, 0.f, 0.f, 0.f};
    const float* wp = ada_w + (size_t)layer * 1024 * 6144 + (size_t)(kc * 64) * 6144 + n0 + 4 * cg;
#pragma unroll 16
    for (int kk = 0; kk < 64; ++kk) { const f32x4 wv = *(const f32x4*)(wp + (size_t)kk * 6144);
#pragma unroll
        for (int v = 0; v < 5; ++v) acc[v] += wv * sv[v * 1024 + kc * 64 + kk]; }
#pragma unroll
    for (int v = 0; v < 5; ++v) red[(kc * 5 + v) * 32 + cg] = acc[v];
    __syncthreads();
    if (tid < 160) { const int v = tid >> 5; f32x4 s = *(const f32x4*)(ada_b + layer * 6144 + n0 + 4 * cg);
#pragma unroll
        for (int k2 = 0; k2 < 16; ++k2) s += red[(k2 * 5 + v) * 32 + cg];
        *(f32x4*)(mod + (size_t)(layer * 5 + v) * 6144 + n0 + 4 * cg) = s; }
    __syncthreads();
}
__device__ __forceinline__ void bias_rows(const bf16_t* Bt, int nrows, const float* shift  , float* bias, int gw, int ngw, int lane) {
    for (int n0 = 4 * gw; n0 < nrows; n0 += 4 * ngw) {
        u32x4 w[4][2]; f32x4 sv[5][4];
#pragma unroll
        for (int r = 0; r < 4; ++r) { w[r][0] = *(const u32x4*)(Bt + (size_t)(n0 + r) * DM + 16 * lane); w[r][1] = *(const u32x4*)(Bt + (size_t)(n0 + r) * DM + 16 * lane + 8); }
#pragma unroll
        for (int v = 0; v < 5; ++v)
#pragma unroll
            for (int q = 0; q < 4; ++q) sv[v][q] = *(const f32x4*)(shift + (size_t)v * 6144 + 16 * lane + 4 * q);
        float res[5][4];
#pragma unroll
        for (int v = 0; v < 5; ++v)
#pragma unroll
            for (int r = 0; r < 4; ++r) { const u32x4 a = w[r][0], c = w[r][1];
                float d = (bflo(a.x) * sv[v][0].x + bfhi(a.x) * sv[v][0].y) + (bflo(a.y) * sv[v][0].z + bfhi(a.y) * sv[v][0].w);
                d += (bflo(a.z) * sv[v][1].x + bfhi(a.z) * sv[v][1].y) + (bflo(a.w) * sv[v][1].z + bfhi(a.w) * sv[v][1].w);
                d += (bflo(c.x) * sv[v][2].x + bfhi(c.x) * sv[v][2].y) + (bflo(c.y) * sv[v][2].z + bfhi(c.y) * sv[v][2].w);
                d += (bflo(c.z) * sv[v][3].x + bfhi(c.z) * sv[v][3].y) + (bflo(c.w) * sv[v][3].z + bfhi(c.w) * sv[v][3].w);
                res[v][r] = wave_sum(d, lane); }
        if (lane == 0) {
#pragma unroll
            for (int v = 0; v < 5; ++v) *(f32x4*)(bias + (size_t)v * nrows + n0) = (f32x4){res[v][0], res[v][1], res[v][2], res[v][3]}; }
    }
}
__device__ __forceinline__ void rms_mod_rows(const float* src_lat, const float* src_ctx, int nrows, const float* g, const float* modl, int sh_off, int sc_off, bf16_t* XN, int gw, int ngw, int lane) {
    for (int row0 = gw; row0 < nrows; row0 += 2 * ngw) {
        const int row1 = row0 + ngw; const bool has1 = row1 < nrows; const int rows[2] = {row0, has1 ? row1 : row0};
        f32x4 v[2][4]; float ss[2] = {0.f, 0.f};
#pragma unroll
        for (int t = 0; t < 2; ++t) { const int row = rows[t]; const float* xr = row >= ML ? src_ctx + (size_t)(row - ML) * DM : src_lat + (size_t)row * DM;
#pragma unroll
            for (int j = 0; j < 4; ++j) v[t][j] = *(const f32x4*)(xr + 4 * lane + 256 * j); }
#pragma unroll
        for (int t = 0; t < 2; ++t)
#pragma unroll
            for (int j = 0; j < 4; ++j) ss[t] += (v[t][j].x * v[t][j].x + v[t][j].y * v[t][j].y) + (v[t][j].z * v[t][j].z + v[t][j].w * v[t][j].w);
#pragma unroll
        for (int t = 0; t < 2; ++t) { if (t == 1 && !has1) break; const int row = rows[t]; const int bidx = row >= ML ? 4 : (row >> 12);
            const float rstd = __builtin_amdgcn_rsqf(wave_sum(ss[t], lane) * (1.0f / DM) + 1e-6f);
            const float* mb = modl + (size_t)bidx * 6144;
#pragma unroll
            for (int j = 0; j < 4; ++j) { const int col = 4 * lane + 256 * j;
                const f32x4 gg = *(const f32x4*)(g + col), sc = *(const f32x4*)(mb + sc_off + col), sh = *(const f32x4*)(mb + sh_off + col);
                const f32x4 y = (v[t][j] * rstd) * gg * (sc + 1.0f) + sh;
                u32x2 w; w.x = pk2(y.x, y.y); w.y = pk2(y.z, y.w);
                *(u32x2*)(XN + (size_t)row * DM + col) = w; } }
    }
}

constexpr float SC_L2 = 0.125f * 1.4426950408889634f, LOG2E = 1.4426950408889634f, NEGBIG = -1e30f;
template <int LAYER>
__device__ __forceinline__ void post_unit(const pg8::Unit u, bf16_t* T, const float* qg, const float* kg, const float* rope, bf16_t* KF, bf16_t* KFC, bf16_t* VF, bf16_t* VFC, LAS unsigned char* vlds, int tid) {
    constexpr int LDT = LAYER == 0 ? EVIN : ODIN, NH = LAYER == 0 ? 2 : 16;
    const int rowbase = u.pm * 256; const bool isctx = rowbase >= ML;
    const int bb = isctx ? ((rowbase - ML) >> 8) : (rowbase >> 12); const int posbase = isctx ? 0 : (rowbase & 4095); const int nkb = isctx ? 8 : 128;
#pragma unroll 1
    for (int gi = 0; gi < 4; ++gi) {
        const int cgp = 4 * u.pn + gi; int kind, h;
        if (LAYER == 0) { if (cgp < 8) { kind = 0; h = 0; } else if (cgp < 16) { kind = 1; h = cgp - 8; } else if (cgp < 18) { kind = 2; h = cgp - 16; } else { kind = 3; h = cgp - 18; } }
        else { if (cgp < 16) { kind = 1; h = cgp; } else if (cgp < 32) { kind = 2; h = cgp - 16; } else { kind = 3; h = cgp - 32; } }
        if (kind == 0) continue;
        const int bh = bb * NH + h;
        u32x4 vin[4];
        if (kind == 3) {
            bf16_t* vdst = isctx ? VFC : VF; LAS bf16_t* vt = (LAS bf16_t*)vlds; constexpr int VP = 264;
#pragma unroll
            for (int pass = 0; pass < 4; ++pass) { const int idx = pass * NTHR + tid, rl = idx & 255, ch = idx >> 8; vin[pass] = *(const u32x4*)(T + (size_t)(rowbase + rl) * LDT + 64 * cgp + 8 * ch); }
#pragma unroll
            for (int pass = 0; pass < 4; ++pass) { const int idx = pass * NTHR + tid, rl = idx & 255, ch = idx >> 8; const u32x4 v = vin[pass]; LAS bf16_t* d0 = vt + (8 * ch) * VP + rl;
                d0[0 * VP] = (bf16_t)(v.x & 0xffffu); d0[1 * VP] = (bf16_t)(v.x >> 16); d0[2 * VP] = (bf16_t)(v.y & 0xffffu); d0[3 * VP] = (bf16_t)(v.y >> 16);
                d0[4 * VP] = (bf16_t)(v.z & 0xffffu); d0[5 * VP] = (bf16_t)(v.z >> 16); d0[6 * VP] = (bf16_t)(v.w & 0xffffu); d0[7 * VP] = (bf16_t)(v.w >> 16); }
            __syncthreads();
#pragma unroll
            for (int i = 0; i < 4; ++i) { const int f = tid + NTHR * i, kb = f >> 8, sp = (f >> 7) & 1, db = (f >> 6) & 1, ln = f & 63, d = 32 * db + (ln & 31), key0 = 32 * kb + 16 * sp + 4 * (ln >> 5);
                const u32x2 lo = *(const LAS u32x2*)(vt + d * VP + key0), hi4 = *(const LAS u32x2*)(vt + d * VP + key0 + 8);
                const u32x4 o = {lo.x, lo.y, hi4.x, hi4.y};
                *(u32x4*)(vdst + ((((size_t)(bh * nkb + (posbase >> 5) + kb) * 2 + sp) * 2 + db) * 64 + ln) * 8) = o; }
            __syncthreads();
            continue;
        }
        const float* gam = kind == 1 ? qg : kg; const float osc = kind == 1 ? SC_L2 : 1.0f;
        bf16_t* kdst = isctx ? KFC : KF;
#pragma unroll
        for (int pass = 0; pass < 4; ++pass) { const int idx = pass * NTHR + tid, rl = idx >> 3, ch = idx & 7; vin[pass] = *(const u32x4*)(T + (size_t)(rowbase + rl) * LDT + 64 * cgp + 8 * ch); }
        const int chl = tid & 7;
        const f32x4 g0 = *(const f32x4*)(gam + 8 * chl), g1 = *(const f32x4*)(gam + 8 * chl + 4);
        const float gg[8] = {g0.x, g0.y, g0.z, g0.w, g1.x, g1.y, g1.z, g1.w};
#pragma unroll
        for (int pass = 0; pass < 4; ++pass) { const int idx = pass * NTHR + tid, rl = idx >> 3, ch = idx & 7; const int row = rowbase + rl;
            bf16_t* ptr = T + (size_t)row * LDT + 64 * cgp + 8 * ch;
            const u32x4 v = vin[pass];
            float xv[8] = {bflo(v.x), bfhi(v.x), bflo(v.y), bfhi(v.y), bflo(v.z), bfhi(v.z), bflo(v.w), bfhi(v.w)};
            float ss = 0.f;
#pragma unroll
            for (int j = 0; j < 8; ++j) ss += xv[j] * xv[j];
            ss += swz_xor<1>(ss); ss += swz_xor<2>(ss); ss += swz_xor<4>(ss);
            const float rstd = __builtin_amdgcn_rsqf(ss * (1.0f / 64.0f) + 1e-6f) * osc;
#pragma unroll
            for (int j = 0; j < 8; ++j) xv[j] = xv[j] * rstd * gg[j];
            if (LAYER == 0 && !isctx) {
                const int pos = row & 4095; const int coord = (ch >= 4) ? (pos & 63) : (pos >> 6);
                const float* tb = rope + (size_t)(coord * 16 + 8 * (ch & 1)) * 2; const bool second = (ch >> 1) & 1;
                f32x4 cs4[4];
#pragma unroll
                for (int j = 0; j < 4; ++j) cs4[j] = *(const f32x4*)(tb + 4 * j);
#pragma unroll
                for (int j = 0; j < 8; ++j) { const float px = swz_xor<2>(xv[j]); const float c = cs4[j >> 1][2 * (j & 1)], sn = cs4[j >> 1][2 * (j & 1) + 1];
                    xv[j] = second ? (xv[j] * c + px * sn) : (xv[j] * c - px * sn); }
            }
            u32x4 o; o.x = pk2(xv[0], xv[1]); o.y = pk2(xv[2], xv[3]); o.z = pk2(xv[4], xv[5]); o.w = pk2(xv[6], xv[7]);
            if (kind == 1) *(u32x4*)ptr = o;
            else { const int pos = posbase + rl; *(u32x4*)(kdst + (((size_t)(bh * nkb + (pos >> 5)) * 4 + (ch >> 1)) * 64 + (pos & 31) + 32 * (ch & 1)) * 8) = o; } }
    }
}

#define CMUL(a, c, s) do { const float _x = (a).x * (c) - (a).y * (s); (a).y = (a).x * (s) + (a).y * (c); (a).x = _x; } while (0)
#define FFT2(a, b) do { const f32x2 _t = (a); (a) = _t + (b); (b) = _t - (b); } while (0)
#define MULNI(a) do { const float _x = (a).y; (a).y = -(a).x; (a).x = _x; } while (0)
__device__ __forceinline__ void fft8(f32x2 (&u)[8]) {
    const float h = 0.70710678118654752f;
    FFT2(u[0], u[4]); FFT2(u[1], u[5]); FFT2(u[2], u[6]); FFT2(u[3], u[7]);
    CMUL(u[5], h, -h); MULNI(u[6]); CMUL(u[7], -h, -h);
    FFT2(u[0], u[2]); FFT2(u[1], u[3]); FFT2(u[4], u[6]); FFT2(u[5], u[7]);
    MULNI(u[3]); MULNI(u[7]);
    FFT2(u[0], u[1]); FFT2(u[2], u[3]); FFT2(u[4], u[5]); FFT2(u[6], u[7]);
}
__device__ __forceinline__ void fft_slab(LAS unsigned char* lds, const bf16_t* T0, bf16_t* A2, int slab, int tid) {
    LAS f32x2* buf = (LAS f32x2*)lds;
#define FI(f, i) ((f) * 4608 + (i) + ((i) >> 3))
    const int b = slab >> 6, ch0 = (slab & 63) * 8;
#pragma unroll
    for (int t = 0; t < 8; ++t) { const int l = tid + NTHR * t; const u32x4 v = *(const u32x4*)(T0 + (size_t)(b * SEQ + l) * EVIN + ch0);
        buf[FI(0, l)] = (f32x2){bflo(v.x), bfhi(v.x)}; buf[FI(1, l)] = (f32x2){bflo(v.y), bfhi(v.y)}; buf[FI(2, l)] = (f32x2){bflo(v.z), bfhi(v.z)}; buf[FI(3, l)] = (f32x2){bflo(v.w), bfhi(v.w)}; }
    __syncthreads();
#pragma unroll 1
    for (int p = 1; p < 4096; p <<= 3) {
        f32x2 u[4][8]; const int k = tid & (p - 1);
#pragma unroll
        for (int f = 0; f < 4; ++f)
#pragma unroll
            for (int t = 0; t < 8; ++t) u[f][t] = buf[FI(f, tid + NTHR * t)];
        if (p > 1) { const float inv = 1.0f / (float)(8 * p);
#pragma unroll
            for (int t = 1; t < 8; ++t) { const float r = (float)(k * t) * inv; const float c = cos_rev(r), s = -sin_rev(r);
#pragma unroll
                for (int f = 0; f < 4; ++f) CMUL(u[f][t], c, s); } }
#pragma unroll
        for (int f = 0; f < 4; ++f) fft8(u[f]);
        __syncthreads();
        const int j = ((tid - k) << 3) + k;
#pragma unroll
        for (int f = 0; f < 4; ++f) {
            buf[FI(f, j)] = u[f][0]; buf[FI(f, j + p)] = u[f][4]; buf[FI(f, j + 2 * p)] = u[f][2]; buf[FI(f, j + 3 * p)] = u[f][6]; buf[FI(f, j + 4 * p)] = u[f][1]; buf[FI(f, j + 5 * p)] = u[f][5]; buf[FI(f, j + 6 * p)] = u[f][3]; buf[FI(f, j + 7 * p)] = u[f][7]; }
        __syncthreads();
    }
    const float sc = 0.5f / 64.0f;
#pragma unroll 2
    for (int t = 0; t < 8; ++t) { const int k = tid + NTHR * t, kn = (4096 - k) & 4095; float re[8], im[8];
#pragma unroll
        for (int f = 0; f < 4; ++f) { const f32x2 Z = buf[FI(f, k)], W = buf[FI(f, kn)];
            re[2 * f] = (Z.x + W.x) * sc; im[2 * f] = (Z.y - W.y) * sc; re[2 * f + 1] = (Z.y + W.y) * sc; im[2 * f + 1] = (W.x - Z.x) * sc; }
        bf16_t* o = A2 + (size_t)(b * SEQ + k) * KOUT0 + ch0;
        u32x4 w; w.x = pk2(re[0], re[1]); w.y = pk2(re[2], re[3]); w.z = pk2(re[4], re[5]); w.w = pk2(re[6], re[7]); *(u32x4*)o = w;
        w.x = pk2(im[0], im[1]); w.y = pk2(im[2], im[3]); w.z = pk2(im[4], im[5]); w.w = pk2(im[6], im[7]); *(u32x4*)(o + 512) = w; }
    __syncthreads();
#undef FI
}
__device__ __forceinline__ void ctxdft_slab(LAS unsigned char* lds, const bf16_t* T0, bf16_t* A2, int slab, int tid) {
    const int b = slab >> 6, ch0 = (slab & 63) * 8;
    LAS float* xs = (LAS float*)lds; LAS f32x2* tab = (LAS f32x2*)(lds + 8192);
    if (tid < 256) { const u32x4 v = *(const u32x4*)(T0 + (size_t)(ML + b * CTXL + tid) * EVIN + ch0);
        LAS float* d = xs + tid * 8; d[0] = bflo(v.x); d[1] = bfhi(v.x); d[2] = bflo(v.y); d[3] = bfhi(v.y); d[4] = bflo(v.z); d[5] = bfhi(v.z); d[6] = bflo(v.w); d[7] = bfhi(v.w);
        const float r = (float)tid * (1.0f / 256.0f); tab[tid] = (f32x2){cos_rev(r), sin_rev(r)}; }
    __syncthreads();
    const int k = tid >> 1, hf = tid & 1;
    if (tid < 258) {
        f32x4 re = {0.f, 0.f, 0.f, 0.f}, im = {0.f, 0.f, 0.f, 0.f};
#pragma unroll 4
        for (int l = 0; l < 256; ++l) { const f32x2 cs = tab[(k * l) & 255]; const f32x4 xv = *(const LAS f32x4*)(xs + l * 8 + 4 * hf); re += xv * cs.x; im -= xv * cs.y; }
        re *= (1.0f / 16.0f); im *= (1.0f / 16.0f);
        bf16_t* o = A2 + (size_t)(ML + b * CTXL + k) * KOUT0 + ch0 + 4 * hf;
        u32x2 w; w.x = pk2(re.x, re.y); w.y = pk2(re.z, re.w);
        u32x2 wi; wi.x = pk2(im.x, im.y); wi.y = pk2(im.z, im.w);
        *(u32x2*)o = w; *(u32x2*)(o + 512) = wi;
        if (k > 0 && k < 128) { bf16_t* o2 = A2 + (size_t)(ML + b * CTXL + 256 - k) * KOUT0 + ch0 + 4 * hf; u32x2 wn; wn.x = pk2(-im.x, -im.y); wn.y = pk2(-im.z, -im.w); *(u32x2*)o2 = w; *(u32x2*)(o2 + 512) = wn; }
    }
    __syncthreads();
}

struct QTile { f32x16 o0, o1; float l; };
__device__ __forceinline__ void tile_init(QTile& t, float l0) {
#pragma unroll
    for (int i = 0; i < 16; ++i) { t.o0[i] = 0.f; t.o1[i] = 0.f; }
    t.l = l0; }
__device__ __forceinline__ float wave_max(float v, int lane) {
    v = fmaxf(v, swz_xor<1>(v)); v = fmaxf(v, swz_xor<2>(v)); v = fmaxf(v, swz_xor<4>(v)); v = fmaxf(v, swz_xor<8>(v)); v = fmaxf(v, swz_xor<16>(v)); v = fmaxf(v, xor32(v, lane));
    return v; }
struct NoMask { __device__ __forceinline__ void operator()(f32x16&) const {} };
struct WinMask { int ql, hi; bool first;
    __device__ __forceinline__ void operator()(f32x16& s) const {
#pragma unroll
        for (int i = 0; i < 16; ++i) { const int cr = (i & 3) + 8 * (i >> 2) + 4 * hi; const bool ok = first ? (cr >= ql) : (cr <= ql); s[i] = ok ? s[i] : NEGBIG; } } };
struct NaMask { const LAS float* tb; int bm;
    __device__ __forceinline__ void operator()(f32x16& s) const {
#pragma unroll
        for (int i = 0; i < 16; ++i) { const int off = (i & 3) + 8 * (i >> 2); const float bv = tb[off]; const bool ok = (unsigned)(bm + off) < 16u; const float sv = s[i] + bv; s[i] = ok ? sv : NEGBIG; } } };
__device__ __forceinline__ void tile_update(QTile& T, const f32x16& s, const bf16x8 (&vf)[4]) {
    float ps = 0.f; unsigned pk[8];
#pragma unroll
    for (int i = 0; i < 16; i += 2) { const float p0 = __builtin_amdgcn_exp2f(s[i]), p1 = __builtin_amdgcn_exp2f(s[i + 1]); ps += p0 + p1; pk[i >> 1] = pk2(p0, p1); }
    T.l += ps;
    const u32x4 pw0 = {pk[0], pk[1], pk[2], pk[3]}, pw1 = {pk[4], pk[5], pk[6], pk[7]};
    const bf16x8 pf0 = __builtin_bit_cast(bf16x8, pw0), pf1 = __builtin_bit_cast(bf16x8, pw1);
    T.o0 = __builtin_amdgcn_mfma_f32_32x32x16_bf16(vf[0], pf0, T.o0, 0, 0, 0); T.o1 = __builtin_amdgcn_mfma_f32_32x32x16_bf16(vf[1], pf0, T.o1, 0, 0, 0);
    T.o0 = __builtin_amdgcn_mfma_f32_32x32x16_bf16(vf[2], pf1, T.o0, 0, 0, 0); T.o1 = __builtin_amdgcn_mfma_f32_32x32x16_bf16(vf[3], pf1, T.o1, 0, 0, 0);
}
__device__ __forceinline__ void ld_frag(bf16x8 (&f)[4], const bf16_t* blk, int lane) {
#pragma unroll
    for (int t = 0; t < 4; ++t) f[t] = *(const bf16x8*)(blk + t * 512 + lane * 8); }
template <class MA, class MB>
__device__ __forceinline__ void attn_step(QTile& A, QTile& B, const bf16x8 (&qa)[4], const bf16x8 (&qb)[4], bf16x8 (&kf)[4], const bf16x8 (&vf)[4], const MA& ma, const MB& mb, const bool active, const float negm0, int lane, const bf16_t* knext) {
    f32x16 s;
#pragma unroll
    for (int i = 0; i < 16; ++i) s[i] = negm0;
#pragma unroll
    for (int t = 0; t < 4; ++t) s = __builtin_amdgcn_mfma_f32_32x32x16_bf16(kf[t], qa[t], s, 0, 0, 0);
    if (active) ma(s);
    tile_update(A, s, vf);
    __builtin_amdgcn_sched_barrier(0);
#pragma unroll
    for (int i = 0; i < 16; ++i) s[i] = negm0;
#pragma unroll
    for (int t = 0; t < 4; ++t) s = __builtin_amdgcn_mfma_f32_32x32x16_bf16(kf[t], qb[t], s, 0, 0, 0);
    ld_frag(kf, knext, lane);
    __builtin_amdgcn_sched_barrier(0);
    if (active) mb(s);
    tile_update(B, s, vf);
}
__device__ __forceinline__ void tile_store(const QTile& st, bf16_t* orow, int lane) {
    const float lt = st.l + xor32(st.l, lane); const float inv = 1.0f / lt; const int hi = lane >> 5; const int pidx = (lane ^ 32) << 2;
#pragma unroll
    for (int db = 0; db < 2; ++db)
#pragma unroll
        for (int k = 0; k < 2; ++k) { const f32x16& o = db == 0 ? st.o0 : st.o1;
            u32x2 e0, e1;
            e0.x = pk2(o[8 * k] * inv, o[8 * k + 1] * inv); e0.y = pk2(o[8 * k + 2] * inv, o[8 * k + 3] * inv);
            e1.x = pk2(o[8 * k + 4] * inv, o[8 * k + 5] * inv); e1.y = pk2(o[8 * k + 6] * inv, o[8 * k + 7] * inv);
            const u32x2 snd = hi ? e0 : e1; u32x2 rcv;
            rcv.x = (unsigned)__builtin_amdgcn_ds_bpermute(pidx, (int)snd.x); rcv.y = (unsigned)__builtin_amdgcn_ds_bpermute(pidx, (int)snd.y);
            const u32x4 w = hi ? (u32x4){rcv.x, rcv.y, e1.x, e1.y} : (u32x4){e0.x, e0.y, rcv.x, rcv.y};
            *(u32x4*)(orow + 32 * db + 16 * k + 8 * hi) = w; }
}
__device__ __forceinline__ void attn_even_unit(int wu, const bf16_t* T0, const bf16_t* KF, const bf16_t* KFC, const bf16_t* VF, const bf16_t* VFC, const float* sink, const float* qg, const float* kg, bf16_t* A2, int lane) {
    const bool isctx = wu >= 2048; int b, qt, hp;
    if (!isctx) { hp = wu & 3; qt = (wu >> 2) & 127; b = wu >> 9; } else { const int w2 = wu - 2048; hp = w2 & 3; qt = (w2 >> 2) & 7; b = w2 >> 5; }
    const int kvh = hp >> 1, hi = lane >> 5, ql = lane & 31, hA = 2 * hp;
    const int qrow = isctx ? ML + b * CTXL + 32 * qt + ql : b * SEQ + 32 * qt + ql;
    bf16x8 qa[4], qb[4];
    { const bf16_t* qp = T0 + (size_t)qrow * EVIN + 512 + 64 * hA + 8 * hi;
#pragma unroll
      for (int t = 0; t < 4; ++t) { qa[t] = *(const bf16x8*)(qp + 16 * t); qb[t] = *(const bf16x8*)(qp + 64 + 16 * t); } }
    const float m0 = SC_L2 * 64.0f * 1.02f * wave_max(fabsf(qg[lane]), lane) * wave_max(fabsf(kg[lane]), lane) + 0.25f;
    QTile A, B; tile_init(A, hi == 0 ? __builtin_amdgcn_exp2f(sink[hA] * LOG2E - m0) : 0.0f); tile_init(B, hi == 0 ? __builtin_amdgcn_exp2f(sink[hA + 1] * LOG2E - m0) : 0.0f);
    const int bh = b * 2 + kvh;
    const bf16_t* kc = KFC + (size_t)(bh * 8) * 2048; const bf16_t* vc = VFC + (size_t)(bh * 8) * 2048;
    int jlo = 0, nwin = 0; const int q0 = 32 * qt;
    if (!isctx) { jlo = q0 >= 128 ? 0 : (128 - q0) >> 5; const int jhi = min(8, (4192 - q0) >> 5); nwin = jhi - jlo + 1; }
    const bf16_t* kw = KF + ((size_t)bh * 128 + (size_t)((q0 - 128 + 32 * jlo) >> 5)) * 2048; const bf16_t* vw = VF + ((size_t)bh * 128 + (size_t)((q0 - 128 + 32 * jlo) >> 5)) * 2048;
    const int nblk = 8 + nwin;
    bf16x8 kf[4], vf[4];
    ld_frag(kf, kc, lane);
#pragma unroll 1
    for (int j = 0; j < nblk; ++j) {
        const int jn = j + 1 < nblk ? j + 1 : j;
        const bf16_t* knext = jn < 8 ? kc + (size_t)jn * 2048 : kw + (size_t)(jn - 8) * 2048;
        ld_frag(vf, j < 8 ? vc + (size_t)j * 2048 : vw + (size_t)(j - 8) * 2048, lane);
        const int jj = j - 8 + jlo;
        const bool act = j >= 8 && (jj == 0 || jj == 8); const WinMask wm{ql, hi, jj == 0};
        attn_step(A, B, qa, qb, kf, vf, wm, wm, act, -m0, lane, knext);
    }
    bf16_t* orow = A2 + (size_t)qrow * KOUT0 + 1024 + 64 * hA;
    tile_store(A, orow, lane); tile_store(B, orow + 64, lane);
}
__device__ __forceinline__ void attn_odd_unit(int wu, const bf16_t* T1, const bf16_t* KF, const bf16_t* KFC, const bf16_t* VF, const bf16_t* VFC, const float* rel_bias, const float* qg, const float* kg, bf16_t* A2, LAS float* tbl, int& hprev, float& m0s, int lane) {
    const int r = wu & 63, h = (wu >> 6) & 15, b = wu >> 10;
    const int hi = lane >> 5, ql = lane & 31;
    if (h != hprev) {
        asm volatile("s_waitcnt lgkmcnt(0)" ::: "memory");
        float bmx = 0.f;
#pragma unroll 6
        for (int idx = lane; idx < 1920; idx += 64) { const int dr = idx >> 7, dc = (idx & 127) - 48; const int dcc = min(max(dc, 0), 30); const float ld = rel_bias[h * 465 + dr * 31 + dcc] * LOG2E; const float bv = (dc == dcc) ? ld : 0.f; tbl[idx] = bv; bmx = fmaxf(bmx, bv); }
        m0s = SC_L2 * 64.0f * 1.02f * wave_max(fabsf(qg[lane]), lane) * wave_max(fabsf(kg[lane]), lane) + wave_max(bmx, lane) + 0.25f;
        hprev = h;
    }
    const float m0 = m0s;
    asm volatile("s_waitcnt lgkmcnt(0)" ::: "memory");
    const int qrow = b * SEQ + r * 64 + ql;
    bf16x8 qa[4], qb[4];
    { const bf16_t* qp = T1 + (size_t)qrow * ODIN + 64 * h + 8 * hi;
#pragma unroll
      for (int t = 0; t < 4; ++t) { qa[t] = *(const bf16x8*)(qp + 16 * t); qb[t] = *(const bf16x8*)(qp + (size_t)32 * ODIN + 16 * t); } }
    QTile A, B; tile_init(A, 0.f); tile_init(B, 0.f);
    const int bh = b * 16 + h; const int r0 = min(max(r - 4, 0), 56);
    const int c0a = max(ql - 8, 0), c0b = min(24 + ql, 48);
    const bf16_t* kc = KFC + (size_t)(bh * 8) * 2048; const bf16_t* vc = VFC + (size_t)(bh * 8) * 2048;
    const bf16_t* kw = KF + ((size_t)bh * 128 + (size_t)(r0 * 2)) * 2048; const bf16_t* vw = VF + ((size_t)bh * 128 + (size_t)(r0 * 2)) * 2048;
    bf16x8 kf[4], vf[4];
    ld_frag(kf, kc, lane);
#pragma unroll 1
    for (int j = 0; j < 24; ++j) {
        const int jn = j + 1 < 24 ? j + 1 : j;
        const bf16_t* knext = jn < 8 ? kc + (size_t)jn * 2048 : kw + (size_t)(jn - 8) * 2048;
        ld_frag(vf, j < 8 ? vc + (size_t)j * 2048 : vw + (size_t)(j - 8) * 2048, lane);
        const int jj = j < 8 ? 0 : j - 8, rr = r0 + (jj >> 1), kbk = jj & 1; const LAS float* trow = tbl + (rr - r + 7) * 128 + 63 + 32 * kbk + 4 * hi;
        const NaMask ma{trow - ql, 32 * kbk + 4 * hi - c0a}, mb{trow - 32 - ql, 32 * kbk + 4 * hi - c0b};
        attn_step(A, B, qa, qb, kf, vf, ma, mb, j >= 8, -m0, lane, knext);
    }
    bf16_t* orow = A2 + (size_t)qrow * DM + 64 * h;
    tile_store(A, orow, lane); tile_store(B, orow + (size_t)32 * DM, lane);
}

template <bool RES_F32, int S>
__device__ __forceinline__ void ctx_fixup(const float* part, const void* res_ctx, bf16_t* xs_ctx, const float* gate4, const float* gam4, bf16_t* xn_ctx, float* rss_ctx, int gw, int ngw, int lane) {
    for (int rl = gw; rl < MC; rl += ngw) { float ss = 0.f;
#pragma unroll
        for (int j = 0; j < 4; ++j) { const int col = 4 * lane + 256 * j; f32x4 acc = {0.f, 0.f, 0.f, 0.f};
            f32x4 pv[S];
#pragma unroll
            for (int s = 0; s < S; ++s) pv[s] = *(const f32x4*)(part + ((size_t)s * 1024 + rl) * 1024 + col);
#pragma unroll
            for (int s = 0; s < S; ++s) acc += pv[s];
            f32x4 r;
            if (RES_F32) r = *(const f32x4*)((const float*)res_ctx + (size_t)rl * DM + col);
            else { const u32x2 rb = *(const u32x2*)((const bf16_t*)res_ctx + (size_t)rl * DM + col); r = (f32x4){bflo(rb.x), bfhi(rb.x), bflo(rb.y), bfhi(rb.y)}; }
            const f32x4 x = r + *(const f32x4*)(gate4 + col) * acc;
            { u32x2 w; w.x = pk2(x.x, x.y); w.y = pk2(x.z, x.w); *(u32x2*)(xs_ctx + (size_t)rl * DM + col) = w; } ss += (x.x * x.x + x.y * x.y) + (x.z * x.z + x.w * x.w);
            const f32x4 y = x * *(const f32x4*)(gam4 + col); u32x2 w; w.x = pk2(y.x, y.y); w.y = pk2(y.z, y.w); *(u32x2*)(xn_ctx + (size_t)rl * DM + col) = w; }
        ss = wave_sum(ss, lane); if (lane == 0) rss_ctx[rl] = ss; }
}
#define RLX_AGENT __ATOMIC_RELAXED, __HIP_MEMORY_SCOPE_AGENT
#define XB_TMO      128
#define XB_XCNT(j)  (256  + 64 * (j))
#define XB_XSUB(j)  (1280 + 64 * (j))
#define XB_XGEN(j)  (2304 + 64 * (j))
#define XB_TOP      3328
#define XB_TOPGEN   3392
#define XCD_BAR_WORDS 3456
#define XB_SPIN_CAP (1u << 18)

__device__ __forceinline__ unsigned xb_ld(unsigned* p)              { return __hip_atomic_load(p, __ATOMIC_RELAXED, __HIP_MEMORY_SCOPE_AGENT); }
__device__ __forceinline__ unsigned xb_add(unsigned* p, unsigned v) { return __hip_atomic_fetch_add(p, v, __ATOMIC_RELAXED, __HIP_MEMORY_SCOPE_AGENT); }
__device__ __forceinline__ unsigned xb_xcc_id() { return (unsigned)__builtin_amdgcn_s_getreg((3 << 11) | 20) & 0xFu; }
#define XB_SPIN(cond, bar) do { unsigned _sp = 0; while (cond) { __builtin_amdgcn_s_sleep(1); \
    if ((++_sp & 255u) == 0u) { if (xb_ld(&(bar)[XB_TMO])) break; if (_sp > XB_SPIN_CAP) { atomicAdd(&(bar)[XB_TMO], 1u); break; } } } } while (0)

struct XcdBarrier {
    unsigned* bar; unsigned x;
    volatile LAS unsigned* st;
};

__device__ __forceinline__ XcdBarrier xcd_barrier_post(unsigned* bar, volatile LAS unsigned* st, const bool leader) {
    XcdBarrier b; b.bar = bar; b.x = xb_xcc_id(); b.st = st;
    if (leader) (void)xb_add(&bar[XB_XCNT(b.x)], 1u);
    return b;
}
__device__ __forceinline__ void xcd_barrier_complete(unsigned* bar, unsigned x, unsigned& nloc, unsigned& nx) {
    const unsigned G = gridDim.x * gridDim.y * gridDim.z;
    unsigned sum, cnt, mine, sp = 0u;
    for (;;) {
        sum = 0u; cnt = 0u; mine = 0u;
#pragma unroll
        for (unsigned j = 0; j < 16; ++j) { const unsigned c = xb_ld(&bar[XB_XCNT(j)]); sum += c; cnt += (c > 0u) ? 1u : 0u; mine = (j == x) ? c : mine; }
        if (sum == G) break;
        __builtin_amdgcn_s_sleep(1);
        if ((++sp & 255u) == 0u) { if (xb_ld(&bar[XB_TMO])) break; if (sp > XB_SPIN_CAP) { atomicAdd(&bar[XB_TMO], 1u); break; } }
    }
    nloc = mine > 0u ? mine : 1u; nx = cnt > 0u ? cnt : 1u;
}

__device__ __forceinline__ void xcd_barrier(const XcdBarrier& b, const bool leader) {
    asm volatile("s_waitcnt vmcnt(0)" ::: "memory");
    __syncthreads();
    if (leader) {
        unsigned* bar = b.bar;
        __builtin_amdgcn_s_waitcnt(0);
        unsigned nloc = b.st[0], nx = b.st[1];
        if (nloc == 0u) { xcd_barrier_complete(bar, b.x, nloc, nx); b.st[0] = nloc; b.st[1] = nx; }
        const unsigned old = xb_add(&bar[XB_XSUB(b.x)], 1u);
        const unsigned gen = old / nloc;
        if (old + 1u == (gen + 1u) * nloc) {
            __builtin_amdgcn_fence(__ATOMIC_RELEASE, "agent");
            asm volatile("s_waitcnt vmcnt(0)" ::: "memory");
            const unsigned og = xb_add(&bar[XB_TOP], 1u);
            const unsigned tg = og / nx;
            if (og + 1u == (tg + 1u) * nx) xb_add(&bar[XB_TOPGEN], 1u);
            else XB_SPIN(xb_ld(&bar[XB_TOPGEN]) == tg, bar);
            __builtin_amdgcn_fence(__ATOMIC_ACQUIRE, "agent");
            xb_add(&bar[XB_XGEN(b.x)], 1u);
            asm volatile("s_waitcnt vmcnt(0)" ::: "memory");
        } else {
            XB_SPIN(xb_ld(&bar[XB_XGEN(b.x)]) == gen, bar);
            __builtin_amdgcn_fence(__ATOMIC_ACQUIRE, "agent");
            asm volatile("s_waitcnt vmcnt(0)" ::: "memory");
        }
    }
    __syncthreads();
}

constexpr int MISC_OFF = 148 * 1024;
#define GRID_BAR() do { int zb_ = 0; asm volatile("" : "+s"(zb_)); const bool leader_ = (wave_s == 0) && (__builtin_amdgcn_mbcnt_hi(~0u, __builtin_amdgcn_mbcnt_lo(~0u, zb_)) == 0); XcdBarrier xb_; xb_.bar = (unsigned*)WSP; xb_.x = xb_xcc_id(); xb_.st = (volatile LAS unsigned*)(lds + MISC_OFF); xcd_barrier(xb_, leader_); } while (0)

#define KARG(i) (*(void* const volatile __attribute__((address_space(4)))*)((const __attribute__((address_space(4))) char*)__builtin_amdgcn_kernarg_segment_ptr() + 8 * (i)))
#define INF(i) ((const float*)KARG(i))
#define WSP ((unsigned char*)KARG(22))
#define OUTP ((unsigned char*)KARG(21))
#define IDS int z_ = 0; asm volatile("" : "+s"(z_)); const int lane = __builtin_amdgcn_mbcnt_hi(~0u, __builtin_amdgcn_mbcnt_lo(~0u, z_)), wave = wave_s, tid = wave * 64 + lane; (void)tid; const int gw = bx * NWAVES + wave, ngw = G * NWAVES; (void)lane; (void)gw; (void)ngw;
__global__ void __launch_bounds__(NTHR, 2) mega_fwd(Params P) {
    extern __shared__ __attribute__((aligned(16))) unsigned char lds_raw[];
    LAS unsigned char* lds = (LAS unsigned char*)lds_raw;
    cg::grid_group grid = cg::this_grid();
    const int G = gridDim.x, bx = blockIdx.x, wave_s = __builtin_amdgcn_readfirstlane(threadIdx.x >> 6);
    { IDS if (tid < 2) ((volatile LAS unsigned*)(lds + MISC_OFF))[tid] = 0u;
      (void)xcd_barrier_post((unsigned*)WSP, (volatile LAS unsigned*)(lds + MISC_OFF), wave == 0 && lane == 0); }
    { IDS unsigned char* ws = WSP; float* mod = (float*)(ws + WS_MOD);
      { float* rss = (float*)(ws + WS_RSS); const int gi = bx * NTHR + tid; if (gi < 3 * MT) rss[gi] = 0.f; if (G * NTHR < 3 * MT) for (int i = gi + G * NTHR; i < 3 * MT; i += G * NTHR) rss[i] = 0.f; }
      for (int it = bx; it < 96 + 256; it += G) {
          int item = it;
          if (G >= 256) { if (bx < 96) { if (it != bx) break; } else { item = -1; } }
          if (item >= 0) { if (item < 96) adaln_unit(lds, INF(1), INF(3), INF(4), INF(5), mod, item, tid); else fourier_w_item(lds, INF(12), (bf16_t*)(ws + WS_WOUT0), item - 96, tid); }
          else break;
      }
      if (G >= 256 && bx >= 96) for (int it = bx - 96; it < 256; it += G - 96) fourier_w_item(lds, INF(12), (bf16_t*)(ws + WS_WOUT0), it, tid);
      if (bx == G - 1) { float* rope = (float*)(ws + WS_ROPE); for (int i = tid; i < 1024; i += NTHR) { const int coord = i >> 4, fi = i & 15; const float inv = __builtin_amdgcn_exp2f(-(float)fi * (13.287712379549449f / 16.0f));
        float r = (float)coord * inv * 0.15915494309189535f; r -= floorf(r); rope[2 * i] = cos_rev(r); rope[2 * i + 1] = sin_rev(r); } }
      __syncthreads();
    }
    { IDS unsigned char* ws = WSP; LAS float* tile = (LAS float*)lds;
        const int skip = (G == 256) ? 96 : 0;
        if (bx >= skip) { const int step = G - skip; int it = bx - skip; f32x4 v[8];
            if (it < 112) tr_load(tdesc0(it, INF(11), INF(12), INF(8), INF(9), INF(10), ws), v, tid);
            while (it < 112) { const int nx = it + step; const TDesc d = tdesc0(it, INF(11), INF(12), INF(8), INF(9), INF(10), ws);
                tr_stage(v, tile, tid); __syncthreads();
                if (nx < 112) tr_load(tdesc0(nx, INF(11), INF(12), INF(8), INF(9), INF(10), ws), v, tid);
                tr_store(d, tile, tid); __syncthreads(); it = nx; } }
    }
    if (G == 0x7fffffff) grid.sync();
    GRID_BAR();
    { IDS unsigned char* ws = WSP; const float* mod = (const float*)(ws + WS_MOD);
      { const int i = bx * NTHR + tid; if (i < 15360) { const int gi = i / 5120, v = (i >> 10) % 5, col = i & 1023; float g, sc;
            if (gi == 0) { g = INF(7)[col]; sc = mod[(size_t)v * 6144 + 4096 + col]; } else if (gi == 1) { g = INF(6)[DM + col]; sc = mod[(size_t)(5 + v) * 6144 + 1024 + col]; } else { g = INF(7)[DM + col]; sc = mod[(size_t)(5 + v) * 6144 + 4096 + col]; }
            ((float*)(ws + WS_GAM))[i] = g * (1.0f + sc); } }
      rms_mod_rows(INF(0), INF(2), MT, INF(6), mod, 0, 1024, (bf16_t*)(ws + WS_XN), gw, ngw, lane); }
    GRID_BAR();
    {
        unsigned char* ws = WSP; bf16_t* T0 = (bf16_t*)(ws + WS_T0);
        pg8::Gemm g{(bf16_t*)(ws + WS_XN), (bf16_t*)(ws + WS_WIN0), MT, EVIN, DM}; pg8::StaticOrder S; S.init(MT, EVIN, G, bx, DM); pg8::EpiBf16 E{T0, EVIN};
        pg8::gemm_phase<pg8::EpiBf16, pg8::StaticOrder, true, true>(lds, g, S, E, wave_s);
        IDS unsigned char* dob = OUTP;
        pg8::Unit u; for (int i = 0; S.next(i, u); ++i) post_unit<0>(u, T0, INF(13), INF(14), (const float*)(ws + WS_ROPE), (bf16_t*)(dob), (bf16_t*)(dob + 8 * MiB), (bf16_t*)(dob + 4 * MiB), (bf16_t*)(dob + 8 * MiB + 512 * 1024), lds, tid);
    }
    {
        IDS unsigned char* ws = WSP; LAS float* tile = (LAS float*)lds;
        const int skip = (G == 256) ? 84 : 0;
        __syncthreads();
        if (bx >= skip) { constexpr int NIT0 = 640 - 112, NIT1 = 8 * (ODIN / 128) + 64 + 3 * 8 * (DFF / 128), NITT = NIT0 + NIT1; const int step = G - skip; int it = bx - skip;
            f32x4 v[8];
#define TD_(i_) ((i_) < NIT0 ? tdesc0(112 + (i_), INF(11), INF(12), INF(8), INF(9), INF(10), ws) : tdesc1((i_) - NIT0, INF(16), INF(17), INF(8), INF(9), INF(10), ws))
            if (it < NITT) tr_load(TD_(it), v, tid);
            while (it < NITT) { const int nx = it + step; const TDesc d = TD_(it);
                tr_stage(v, tile, tid); __syncthreads();
                if (nx < NITT) tr_load(TD_(nx), v, tid);
                tr_store(d, tile, tid); __syncthreads();
                it = nx; }
#undef TD_
        }
    }
    GRID_BAR();
    {
        IDS unsigned char* ws = WSP; bf16_t *T0 = (bf16_t*)(ws + WS_T0), *A20 = (bf16_t*)(ws + WS_A20);
        for (int s0 = bx; s0 < 256; s0 += G) { const int s = (G == 256) ? ((s0 & 7) * 32 + (s0 >> 3)) : s0; fft_slab(lds, T0, A20, s, tid); }
    }
    {   IDS unsigned char* ws = WSP; bf16_t *T0 = (bf16_t*)(ws + WS_T0), *A20 = (bf16_t*)(ws + WS_A20);
        for (int s0 = bx; s0 < 256; s0 += G) { const int s = (G == 256) ? ((s0 & 7) * 32 + (s0 >> 3)) : s0; ctxdft_slab(lds, T0, A20, s, tid); }
    }
    {
        IDS unsigned char* ws = WSP; unsigned char* dob = OUTP; bf16_t *T0 = (bf16_t*)(ws + WS_T0), *A20 = (bf16_t*)(ws + WS_A20);
        const bf16_t *KF0 = (bf16_t*)(dob), *VF0 = (bf16_t*)(dob + 4 * MiB), *KFC0 = (bf16_t*)(dob + 8 * MiB), *VFC0 = (bf16_t*)(dob + 8 * MiB + 512 * 1024);
        const int vcu = (G % 8 == 0) ? (bx & 7) * (G >> 3) + (bx >> 3) : bx; const int gwv = vcu * NWAVES + wave;
        int wu = gwv; bool extra = false;
        for (;;) {
            if (!extra) { if (wu >= 2048) { extra = true; if ((gwv & 15) != 0) break; wu = 2048 + (gwv >> 4); continue; } }
            else if (wu >= 2176) break;
            attn_even_unit(wu, T0, KF0, KFC0, VF0, VFC0, INF(15), INF(13), INF(14), A20, lane);
            wu += extra ? (ngw >> 4) : ngw;
        }
    }
    GRID_BAR();
    {
        unsigned char* ws = WSP; bf16_t* XS = (bf16_t*)(ws + WS_XS);
        pg8::Gemm g{(bf16_t*)(ws + WS_A20), (bf16_t*)(ws + WS_WOUT0), MT, DM, KOUT0}; pg8::TailSplitOrder S; S.init(ML, MT, DM, G, bx, KOUT0, 6);
        pg8::EpiResGateN<true> E{INF(0), INF(2), XS, XS + (size_t)ML * DM, (const float*)(ws + WS_MOD) + 2048, (const float*)(ws + WS_GAM), (bf16_t*)(ws + WS_XN), (float*)(ws + WS_RSS), (float*)(ws + WS_T0), KOUT0 / 64};
        pg8::gemm_phase<pg8::EpiResGateN<true>, pg8::TailSplitOrder, true, true>(lds, g, S, E, wave_s);
    }
    { IDS unsigned char* ws = WSP; const int skip = (G == 256) ? 96 : 0;
      if (bx >= skip) bias_rows((const bf16_t*)(ws + WS_WGU0), NGU, (const float*)(ws + WS_MOD) + 3072, (float*)(ws + WS_BIAS), (bx - skip) * NWAVES + wave, (G - skip) * NWAVES, lane); }
    GRID_BAR();
    {   IDS unsigned char* ws = WSP; bf16_t* XS = (bf16_t*)(ws + WS_XS);
        ctx_fixup<true, 6>((const float*)(ws + WS_T0), INF(2), XS + (size_t)ML * DM, (const float*)(ws + WS_MOD) + 4 * 6144 + 2048, (const float*)(ws + WS_GAM) + 4 * DM, (bf16_t*)(ws + WS_XN) + (size_t)ML * DM, (float*)(ws + WS_RSS) + ML, gw, ngw, lane);
    }
    GRID_BAR();
    {   unsigned char* ws = WSP; pg8::Gemm g{(bf16_t*)(ws + WS_XN), (bf16_t*)(ws + WS_WGU0), MT, NGU, DM}; pg8::StaticOrder S; S.init(MT, NGU, G, bx, DM); pg8::EpiSwiGLUN E{(bf16_t*)(ws + WS_BIG), (const float*)(ws + WS_RSS), (const float*)(ws + WS_BIAS)};
        pg8::gemm_phase<pg8::EpiSwiGLUN, pg8::StaticOrder, true, true>(lds, g, S, E, wave_s); }
    GRID_BAR();
    {   unsigned char* ws = WSP; bf16_t* XS = (bf16_t*)(ws + WS_XS);
        pg8::Gemm g{(bf16_t*)(ws + WS_BIG), (bf16_t*)(ws + WS_WD0), MT, DM, DFF}; pg8::TailSplitOrder S; S.init(ML, MT, DM, G, bx, DFF, 11);
        pg8::EpiResGateN<false> E{XS, XS + (size_t)ML * DM, XS, XS + (size_t)ML * DM, (const float*)(ws + WS_MOD) + 5120, (const float*)(ws + WS_GAM) + 5 * DM, (bf16_t*)(ws + WS_XN), (float*)(ws + WS_RSS) + MT, (float*)OUTP, DFF / 64};
        pg8::gemm_phase<pg8::EpiResGateN<false>, pg8::TailSplitOrder, true, true>(lds, g, S, E, wave_s); }
    GRID_BAR();
    {   IDS unsigned char* ws = WSP; bf16_t* XS = (bf16_t*)(ws + WS_XS);
        ctx_fixup<false, 11>((const float*)OUTP, XS + (size_t)ML * DM, XS + (size_t)ML * DM, (const float*)(ws + WS_MOD) + 4 * 6144 + 5120, (const float*)(ws + WS_GAM) + 5 * DM + 4 * DM, (bf16_t*)(ws + WS_XN) + (size_t)ML * DM, (float*)(ws + WS_RSS) + MT + ML, gw, ngw, lane);
    }
    {
        IDS unsigned char* ws = WSP; const float* mod = (const float*)(ws + WS_MOD); float* bias = (float*)(ws + WS_BIAS);
        const int skip = 0;
        if (bx >= skip) { const int gw2 = (bx - skip) * NWAVES + wave, ngw2 = (G - skip) * NWAVES;
            bias_rows((const bf16_t*)(ws + WS_WIN1), ODIN, mod + 5 * 6144, bias + 5 * NGU, gw2, ngw2, lane);
            bias_rows((const bf16_t*)(ws + WS_WGU1), NGU, mod + 5 * 6144 + 3072, bias + 5 * NGU + 5 * ODIN, gw2, ngw2, lane); }
    }
    GRID_BAR();
    {   unsigned char* ws = WSP; bf16_t* T1 = (bf16_t*)(ws + WS_BIG);
        pg8::Gemm g{(bf16_t*)(ws + WS_XN), (bf16_t*)(ws + WS_WIN1), MT, ODIN, DM}; pg8::StaticOrder S; S.init(MT, ODIN, G, bx, DM); pg8::EpiBf16N E{T1, ODIN, (const float*)(ws + WS_RSS) + MT, (const float*)(ws + WS_BIAS) + 5 * NGU};
        pg8::gemm_phase<pg8::EpiBf16N, pg8::StaticOrder, true, true>(lds, g, S, E, wave_s);
        IDS unsigned char* dob = OUTP;
        pg8::Unit u; for (int i = 0; S.next(i, u); ++i) post_unit<1>(u, T1, INF(18), INF(19), nullptr, (bf16_t*)(dob), (bf16_t*)(ws + 1 * MiB), (bf16_t*)(dob + 32 * MiB), (bf16_t*)(ws + 3 * MiB), lds, tid);
    }
    GRID_BAR();
    { IDS unsigned char* ws = WSP; unsigned char* dob = OUTP; LAS float* tbl = (LAS float*)(lds + wave * 8192);
      const int vcu = (G % 8 == 0) ? (bx & 7) * (G >> 3) + (bx >> 3) : bx;
      int hprev = -1; float m0s = 0.f;
      for (int wu = vcu * NWAVES + wave; wu < 4096; wu += ngw) attn_odd_unit(wu, (const bf16_t*)(ws + WS_BIG), (const bf16_t*)(dob), (const bf16_t*)(ws + 1 * MiB), (const bf16_t*)(dob + 32 * MiB), (const bf16_t*)(ws + 3 * MiB), INF(20), INF(18), INF(19), (bf16_t*)(ws + WS_XN), tbl, hprev, m0s, lane); }
    GRID_BAR();
    {   unsigned char* ws = WSP; bf16_t* XS = (bf16_t*)(ws + WS_XS);
        pg8::Gemm g{(bf16_t*)(ws + WS_XN), (bf16_t*)(ws + WS_WOUT1), ML, DM, DM}; pg8::StaticOrder S; S.init(ML, DM, G, bx, DM); pg8::EpiResGateN<false> E{XS, XS, XS, XS, (const float*)(ws + WS_MOD) + 5 * 6144 + 2048, (const float*)(ws + WS_GAM) + 10 * DM, (bf16_t*)OUTP, (float*)(ws + WS_RSS) + 2 * MT, nullptr, DM / 64};
        pg8::gemm_phase<pg8::EpiResGateN<false>, pg8::StaticOrder, true, true>(lds, g, S, E, wave_s); }
    GRID_BAR();
    {   unsigned char* ws = WSP; pg8::Gemm g{(bf16_t*)OUTP, (bf16_t*)(ws + WS_WGU1), ML, NGU, DM}; pg8::StaticOrder S; S.init(ML, NGU, G, bx, DM); pg8::EpiSwiGLUN E{(bf16_t*)(ws + WS_BIG), (const float*)(ws + WS_RSS) + 2 * MT, (const float*)(ws + WS_BIAS) + 5 * NGU + 5 * ODIN};
        pg8::gemm_phase<pg8::EpiSwiGLUN, pg8::StaticOrder, true, true>(lds, g, S, E, wave_s); }
    GRID_BAR();
    {   unsigned char* ws = WSP; const bf16_t* XS = (const bf16_t*)(ws + WS_XS); float* outp = (float*)OUTP;
        pg8::Gemm g{(bf16_t*)(ws + WS_BIG), (bf16_t*)(ws + WS_WD1), ML, DM, DFF}; pg8::StaticOrder S; S.init(ML, DM, G, bx, DFF); pg8::EpiResGate E{XS, outp, (const float*)(ws + WS_MOD) + 5 * 6144 + 5120};
        pg8::gemm_phase<pg8::EpiResGate, pg8::StaticOrder, true, true>(lds, g, S, E, wave_s); }
}

extern "C" void kernel_launch(void* const* d_in, const int* in_sizes, int n_in, void* d_out, int out_size, void* d_ws, size_t ws_size, hipStream_t stream) {
    static int grid = 0;
    if (grid == 0) {
        if (n_in != 21 || out_size != ML * DM || ws_size < WS_END) { fprintf(stderr, "kernel_launch: unexpected shapes (n_in %d out %d ws %zu)\n", n_in, out_size, ws_size); grid = -1; return; }
        int dev = 0, cus = 0, per_cu = 0;
        (void)hipGetDevice(&dev); (void)hipDeviceGetAttribute(&cus, hipDeviceAttributeMultiprocessorCount, dev);
        if (hipFuncSetAttribute((const void*)mega_fwd, hipFuncAttributeMaxDynamicSharedMemorySize, LDS_BYTES) != hipSuccess) { fprintf(stderr, "kernel_launch: hipFuncSetAttribute failed\n"); grid = -1; return; }
        if (hipOccupancyMaxActiveBlocksPerMultiprocessor(&per_cu, (const void*)mega_fwd, NTHR, LDS_BYTES) != hipSuccess || per_cu < 1) per_cu = 1;
        (void)hipGetLastError();
        grid = cus * per_cu; if (grid < 1) grid = 256;
    }
    if (grid < 0) return;
    if (hipMemsetAsync(d_ws, 0, 16384, stream) != hipSuccess) { fprintf(stderr, "kernel_launch: hipMemsetAsync of the barrier words failed\n"); return; }
    Params p{};
    const float** pf = (const float**)&p;
    for (int i = 0; i < 21; ++i) pf[i] = (const float*)d_in[i];
    p.out = (float*)d_out; p.ws = (unsigned char*)d_ws;
    void* args[] = {&p};
    hipError_t e = hipLaunchCooperativeKernel((const void*)mega_fwd, dim3(grid), dim3(NTHR), args, LDS_BYTES, stream);
    if (e != hipSuccess) fprintf(stderr, "cooperative launch failed: %s (grid %d)\n", hipGetErrorString(e), grid);
}
```

```cpp
#include <hip/hip_runtime.h>
#include <hip/hip_cooperative_groups.h>
#include <cstdio>
#include <cstdint>
namespace cg = cooperative_groups;
namespace pg8 {
#define PG8_LAS __attribute__((address_space(3)))
typedef unsigned short bf16_t;
typedef short bf16x8 __attribute__((ext_vector_type(8)));
typedef float f32x4 __attribute__((ext_vector_type(4)));
typedef unsigned u32x4 __attribute__((ext_vector_type(4)));
constexpr int BM = 256, BK = 64, HALF = 128, HTB = HALF * BK * 2  , STAGE_BYTES = 8 * HTB, NXCD = 8, WGM = 4;

__host__ __device__ __forceinline__ int lds_byte(int r, int c) { const int st = (r >> 4) * 2 + (c >> 5), rr = r & 15, cc = c & 31, ob = rr * 64 + cc * 2; return st * 1024 + (ob ^ (((ob >> 9) & 1) << 5)); }
__host__ __device__ __forceinline__ void stage_rc(int b, int& R, int& C) { const int st = b / 1024, sb = b % 1024, swz = sb ^ (((sb >> 9) & 1) << 5); R = (st >> 1) * 16 + swz / 64; C = (st & 1) * 32 + (swz % 64) / 2; }
__host__ __device__ __forceinline__ int perm32(int rho) { const int n = rho >> 4, i = rho & 15; return 8 * (i >> 2) + 4 * n + (i & 3); }

struct Unit { int pm, pn, k0, nt; };
struct Gemm { const bf16_t* A; const bf16_t* Bt; int M, N, K; };

struct StaticOrder {
    int nM, nN, nwg, G, c, ntf;
    __host__ __device__ void init(int M, int N, int G_, int c_, int K_) { nM = M / BM; nN = N / BM; nwg = nM * nN; G = G_; c = c_; ntf = K_ / BK; }
    __host__ __device__ bool next(int i, Unit& u) const {
        const long L = (long)i * G + c; if (L >= nwg) return false;
        int wgid = (int)L; { const int q = nwg / NXCD, r = nwg % NXCD, xcd = wgid % NXCD, off = wgid / NXCD; wgid = (xcd < r ? xcd * (q + 1) : r * (q + 1) + (xcd - r) * q) + off; }
        const int nig = WGM * nN, gid = wgid / nig, fm = gid * WGM, gsz = (nM - fm) < WGM ? (nM - fm) : WGM;
        u.pm = fm + ((wgid % nig) % gsz); u.pn = (wgid % nig) / gsz; u.k0 = 0; u.nt = ntf; return true;
    }
    __device__ __forceinline__ void a_ready(const Unit&) const {}
    __device__ __forceinline__ void done(const Unit&) const {}
};

struct TailSplitOrder {
    StaticOrder so; int nfull, nslices, S, nts, nMfull, nN, G, c;
    __host__ __device__ void init(int Mfull, int Mtot, int N, int G_, int c_, int K_, int S_) { so.init(Mfull, N, G_, c_, K_); nfull = so.nwg; nMfull = Mfull / BM; nN = N / BM; S = S_; nts = (K_ / BK) / S_; nslices = ((Mtot - Mfull) / BM) * nN * S_; G = G_; c = c_; }
    __host__ __device__ bool next(int i, Unit& u) const {
        const long L = (long)i * G + c; if (L < nfull) return so.next(i, u);
        const int s = (int)(L - nfull); if (s >= nslices) return false;
        const int tu = s / S, sl = s % S; u.pm = nMfull + tu / nN; u.pn = tu % nN; u.k0 = sl * nts * BK; u.nt = nts; return true;
    }
    __device__ __forceinline__ void a_ready(const Unit&) const {}
    __device__ __forceinline__ void done(const Unit&) const {}
};

__device__ __forceinline__ unsigned cvt_pk_bf16(float lo, float hi) { unsigned r; asm volatile("v_cvt_pk_bf16_f32 %0, %1, %2" : "=v"(r) : "v"(lo), "v"(hi)); return r; }
typedef float f32x2 __attribute__((ext_vector_type(2)));
typedef unsigned u32x2 __attribute__((ext_vector_type(2)));

struct EpiBf16 {
    static constexpr bool PERM = true, AFTER_DRAIN = false;
    bf16_t* O; int ldc;
    __device__ __forceinline__ void operator()(const f32x4 (&acc)[2][2][4][2], const Unit& u, int wr, int wc, int fr, int fq) const {
        const int row0 = u.pm * BM + wr * 64 + fr; const int col0 = u.pn * BM + wc * 32 + 8 * fq;
#pragma unroll
        for (int ai = 0; ai < 2; ++ai)
#pragma unroll
            for (int m = 0; m < 4; ++m) { bf16_t* rowp = O + (size_t)(row0 + ai * HALF + m * 16) * ldc + col0;
#pragma unroll
                for (int bj = 0; bj < 2; ++bj) { const f32x4 v0 = acc[ai][bj][m][0], v1 = acc[ai][bj][m][1];
                    u32x4 w; w.x = cvt_pk_bf16(v0[0], v0[1]); w.y = cvt_pk_bf16(v0[2], v0[3]); w.z = cvt_pk_bf16(v1[0], v1[1]); w.w = cvt_pk_bf16(v1[2], v1[3]);
                    *(u32x4*)(rowp + bj * HALF) = w; } }
    }
};
struct EpiResGate {
    static constexpr bool PERM = true, AFTER_DRAIN = false;
    const bf16_t* res; float* out; const float* gate;
    __device__ __forceinline__ void operator()(const f32x4 (&acc)[2][2][4][2], const Unit& u, int wr, int wc, int fr, int fq) const {
        const int rowbase = u.pm * BM; const int bidx = rowbase >> 12;
        const bf16_t* rs = res + (size_t)rowbase * 1024; float* o = out + (size_t)rowbase * 1024;
        const int col0 = u.pn * BM + wc * 32 + 8 * fq;
        f32x4 gv[2][2];
#pragma unroll
        for (int bj = 0; bj < 2; ++bj)
#pragma unroll
            for (int n = 0; n < 2; ++n) gv[bj][n] = *(const f32x4*)(gate + (size_t)bidx * 6144 + col0 + bj * HALF + 4 * n);
#pragma unroll
        for (int am = 0; am < 8; am += 4) { const int ai = am >> 2; u32x4 rbh[4][2];
#pragma unroll
            for (int mm = 0; mm < 4; ++mm) { const size_t off = (size_t)(ai * HALF + wr * 64 + ((am & 3) + mm) * 16 + fr) * 1024 + col0;
#pragma unroll
                for (int bj = 0; bj < 2; ++bj) rbh[mm][bj] = *(const u32x4*)(rs + off + bj * HALF); }
#pragma unroll
            for (int mm = 0; mm < 4; ++mm) { const int m = (am & 3) + mm; const size_t off = (size_t)(ai * HALF + wr * 64 + m * 16 + fr) * 1024 + col0;
#pragma unroll
                for (int bj = 0; bj < 2; ++bj) { const u32x4 rb = rbh[mm][bj];
                    const f32x4 b0 = {__uint_as_float(rb.x << 16), __uint_as_float(rb.x & 0xffff0000u), __uint_as_float(rb.y << 16), __uint_as_float(rb.y & 0xffff0000u)};
                    const f32x4 b1 = {__uint_as_float(rb.z << 16), __uint_as_float(rb.z & 0xffff0000u), __uint_as_float(rb.w << 16), __uint_as_float(rb.w & 0xffff0000u)};
                    *(f32x4*)(o + off + bj * HALF) = b0 + gv[bj][0] * acc[ai][bj][m][0];
                    *(f32x4*)(o + off + bj * HALF + 4) = b1 + gv[bj][1] * acc[ai][bj][m][1]; } } }
    }
};
template <bool RES_F32> struct EpiResGateN {
    static constexpr bool PERM = true, AFTER_DRAIN = false;
    const void* res_lat; const void* res_ctx; bf16_t* out_lat; bf16_t* out_ctx; const float* gate; const float* gam; bf16_t* XNo; float* rss; float* part; int ntfull;
    __device__ __forceinline__ void operator()(const f32x4 (&acc)[2][2][4][2], const Unit& u, int wr, int wc, int fr_in, int fq_in) const {
        int fr = fr_in, fq = fq_in; asm volatile("" : "+v"(fr), "+v"(fq));
        if (u.nt != ntfull) {
            const int sl = u.k0 / (u.nt * BK); float* pp = part + ((size_t)sl * 1024 + (size_t)(u.pm - 64) * BM) * 1024 + u.pn * BM + wc * 32 + 8 * fq;
#pragma unroll
            for (int ai = 0; ai < 2; ++ai)
#pragma unroll
                for (int m = 0; m < 4; ++m) { const size_t off = (size_t)(ai * HALF + wr * 64 + m * 16 + fr) * 1024;
#pragma unroll
                    for (int bj = 0; bj < 2; ++bj)
#pragma unroll
                        for (int n = 0; n < 2; ++n) *(f32x4*)(pp + off + bj * HALF + 4 * n) = acc[ai][bj][m][n]; }
            return;
        }
        const int rowbase = u.pm * BM; const bool isctx = rowbase >= 16384; const int bidx = isctx ? 4 : (rowbase >> 12);
        const size_t rb_ = isctx ? (size_t)(rowbase - 16384) * 1024 : (size_t)rowbase * 1024;
        const float* resf = (const float*)(isctx ? res_ctx : res_lat) + rb_; const bf16_t* resh = (const bf16_t*)(isctx ? res_ctx : res_lat) + rb_;
        bf16_t* out = (isctx ? out_ctx : out_lat) + rb_;
        bf16_t* xn = XNo + (size_t)rowbase * 1024; float* rs = rss + rowbase;
        const int col0 = u.pn * BM + wc * 32 + 8 * fq;
        f32x4 gv[2][2], gm[2][2];
#pragma unroll
        for (int bj = 0; bj < 2; ++bj)
#pragma unroll
            for (int n = 0; n < 2; ++n) { gv[bj][n] = *(const f32x4*)(gate + (size_t)bidx * 6144 + col0 + bj * HALF + 4 * n); gm[bj][n] = *(const f32x4*)(gam + (size_t)bidx * 1024 + col0 + bj * HALF + 4 * n); }
#pragma unroll
        for (int ai = 0; ai < 2; ++ai) {
            constexpr int MG = RES_F32 ? 2 : 4;
#pragma unroll
            for (int mb = 0; mb < 4; mb += MG) {
                u32x4 rbh[MG][2]; f32x4 rbf[MG][2][2];
#pragma unroll
                for (int mm = 0; mm < MG; ++mm) { const size_t off = (size_t)(ai * HALF + wr * 64 + (mb + mm) * 16 + fr) * 1024 + col0;
#pragma unroll
                    for (int bj = 0; bj < 2; ++bj) { if (RES_F32) { rbf[mm][bj][0] = *(const f32x4*)(resf + off + bj * HALF); rbf[mm][bj][1] = *(const f32x4*)(resf + off + bj * HALF + 4); } else rbh[mm][bj] = *(const u32x4*)(resh + off + bj * HALF); } }
#pragma unroll
                for (int mm = 0; mm < MG; ++mm) { const int m = mb + mm; const int r = ai * HALF + wr * 64 + m * 16 + fr; const size_t off = (size_t)r * 1024 + col0; float ss = 0.f;
#pragma unroll
                    for (int bj = 0; bj < 2; ++bj) { f32x4 b0, b1;
                        if (RES_F32) { b0 = rbf[mm][bj][0]; b1 = rbf[mm][bj][1]; }
                        else { const u32x4 rb = rbh[mm][bj];
                            b0 = (f32x4){__uint_as_float(rb.x << 16), __uint_as_float(rb.x & 0xffff0000u), __uint_as_float(rb.y << 16), __uint_as_float(rb.y & 0xffff0000u)};
                            b1 = (f32x4){__uint_as_float(rb.z << 16), __uint_as_float(rb.z & 0xffff0000u), __uint_as_float(rb.w << 16), __uint_as_float(rb.w & 0xffff0000u)}; }
                        const f32x4 o0 = b0 + gv[bj][0] * acc[ai][bj][m][0], o1 = b1 + gv[bj][1] * acc[ai][bj][m][1];
                        { u32x4 wo; wo.x = cvt_pk_bf16(o0[0], o0[1]); wo.y = cvt_pk_bf16(o0[2], o0[3]); wo.z = cvt_pk_bf16(o1[0], o1[1]); wo.w = cvt_pk_bf16(o1[2], o1[3]); *(u32x4*)(out + off + bj * HALF) = wo; }
                        ss += ((o0[0] * o0[0] + o0[1] * o0[1]) + (o0[2] * o0[2] + o0[3] * o0[3])) + ((o1[0] * o1[0] + o1[1] * o1[1]) + (o1[2] * o1[2] + o1[3] * o1[3]));
                        const f32x4 y0 = o0 * gm[bj][0], y1 = o1 * gm[bj][1];
                        { u32x4 w; w.x = cvt_pk_bf16(y0[0], y0[1]); w.y = cvt_pk_bf16(y0[2], y0[3]); w.z = cvt_pk_bf16(y1[0], y1[1]); w.w = cvt_pk_bf16(y1[2], y1[3]); *(u32x4*)(xn + off + bj * HALF) = w; } }
                    ss += __int_as_float(__builtin_amdgcn_ds_swizzle(__float_as_int(ss), (16 << 10) | 0x1F));
                    ss += __int_as_float(__builtin_amdgcn_ds_bpermute((((fq * 16 + fr) ^ 32) << 2), __float_as_int(ss)));
                    if (fq == 0) __hip_atomic_fetch_add(rs + r, ss, __ATOMIC_RELAXED, __HIP_MEMORY_SCOPE_AGENT); }
            }
        }
    }
};
struct EpiBf16N {
    static constexpr bool PERM = true, AFTER_DRAIN = false;
    bf16_t* O; int ldc; const float* rss; const float* bias;
    __device__ __forceinline__ void operator()(const f32x4 (&acc)[2][2][4][2], const Unit& u, int wr, int wc, int fr, int fq) const {
        const int rowbase = u.pm * BM; const int bidx = rowbase >= 16384 ? 4 : (rowbase >> 12);
        const int row0 = rowbase + wr * 64 + fr; const int col0 = u.pn * BM + wc * 32 + 8 * fq;
        f32x4 bv[2][2];
#pragma unroll
        for (int bj = 0; bj < 2; ++bj)
#pragma unroll
            for (int n = 0; n < 2; ++n) bv[bj][n] = *(const f32x4*)(bias + (size_t)bidx * ldc + col0 + bj * HALF + 4 * n);
        float rstd8[2][4];
#pragma unroll
        for (int ai = 0; ai < 2; ++ai)
#pragma unroll
            for (int m = 0; m < 4; ++m) rstd8[ai][m] = __builtin_amdgcn_rsqf(rss[row0 + ai * HALF + m * 16] * (1.0f / 1024.0f) + 1e-6f);
#pragma unroll
        for (int ai = 0; ai < 2; ++ai)
#pragma unroll
            for (int m = 0; m < 4; ++m) { const int row = row0 + ai * HALF + m * 16; const float rstd = rstd8[ai][m];
                bf16_t* rowp = O + (size_t)row * ldc + col0;
#pragma unroll
                for (int bj = 0; bj < 2; ++bj) { const f32x4 v0 = acc[ai][bj][m][0] * rstd + bv[bj][0], v1 = acc[ai][bj][m][1] * rstd + bv[bj][1];
                    u32x4 w; w.x = cvt_pk_bf16(v0[0], v0[1]); w.y = cvt_pk_bf16(v0[2], v0[3]); w.z = cvt_pk_bf16(v1[0], v1[1]); w.w = cvt_pk_bf16(v1[2], v1[3]);
                    *(u32x4*)(rowp + bj * HALF) = w; } }
    }
};
struct EpiSwiGLUN {
    static constexpr bool PERM = true, AFTER_DRAIN = false;
    bf16_t* Hh; const float* rss; const float* bias;
    __device__ __forceinline__ void operator()(const f32x4 (&acc)[2][2][4][2], const Unit& u, int wr, int wc, int fr, int fq) const {
        const int rowbase = u.pm * BM; const int bidx = rowbase >= 16384 ? 4 : (rowbase >> 12);
        const int row0 = rowbase + wr * 64 + fr; const int f0 = u.pn * 128 + wc * 32 + 8 * fq; const int c0 = u.pn * BM + wc * 32 + 8 * fq;
        f32x4 bg[2], bu[2];
#pragma unroll
        for (int bj = 0; bj < 2; ++bj) { bg[bj] = *(const f32x4*)(bias + (size_t)bidx * 5632 + c0 + bj * HALF); bu[bj] = *(const f32x4*)(bias + (size_t)bidx * 5632 + c0 + bj * HALF + 4); }
        float rstd8[2][4];
#pragma unroll
        for (int ai = 0; ai < 2; ++ai)
#pragma unroll
            for (int m = 0; m < 4; ++m) rstd8[ai][m] = __builtin_amdgcn_rsqf(rss[row0 + ai * HALF + m * 16] * (1.0f / 1024.0f) + 1e-6f);
#pragma unroll
        for (int ai = 0; ai < 2; ++ai)
#pragma unroll
            for (int m = 0; m < 4; ++m) { const int row = row0 + ai * HALF + m * 16; const float rstd = rstd8[ai][m];
                f32x4 o[2];
#pragma unroll
                for (int bj = 0; bj < 2; ++bj) { const f32x4 g = acc[ai][bj][m][0] * rstd + bg[bj], up = acc[ai][bj][m][1] * rstd + bu[bj];
#pragma unroll
                    for (int j = 0; j < 4; ++j) { const float e = __builtin_amdgcn_exp2f(-1.4426950408889634f * g[j]); o[bj][j] = g[j] * __builtin_amdgcn_rcpf(1.0f + e) * up[j]; } }
                u32x4 w; w.x = cvt_pk_bf16(o[0][0], o[0][1]); w.y = cvt_pk_bf16(o[0][2], o[0][3]); w.z = cvt_pk_bf16(o[1][0], o[1][1]); w.w = cvt_pk_bf16(o[1][2], o[1][3]);
                *(u32x4*)(Hh + (size_t)row * 2816 + f0) = w; }
    }
};
struct EpiSwiGLU {
    static constexpr bool PERM = false, AFTER_DRAIN = false;
    bf16_t* Hh;
    __device__ __forceinline__ void operator()(const f32x4 (&acc)[2][2][4][2], const Unit& u, int wr, int wc, int fr, int fq) const {
        const int row0 = u.pm * BM + wr * 64 + fr; const int f0 = u.pn * 128 + wc * 16 + 4 * fq;
#pragma unroll
        for (int ai = 0; ai < 2; ++ai)
#pragma unroll
            for (int m = 0; m < 4; ++m) { bf16_t* rowp = Hh + (size_t)(row0 + ai * HALF + m * 16) * 2816 + f0;
#pragma unroll
                for (int bj = 0; bj < 2; ++bj) { const f32x4 g = acc[ai][bj][m][0], up = acc[ai][bj][m][1]; f32x4 o;
#pragma unroll
                    for (int j = 0; j < 4; ++j) { const float e = __builtin_amdgcn_exp2f(-1.4426950408889634f * g[j]); o[j] = g[j] * __builtin_amdgcn_rcpf(1.0f + e) * up[j]; }
                    u32x2 w; w.x = cvt_pk_bf16(o[0], o[1]); w.y = cvt_pk_bf16(o[2], o[3]);
                    *(u32x2*)(rowp + bj * 64) = w; } }
    }
};
template <class Epi, class Sched, bool ALIGN_EPI = false, bool SP2 = false>
__device__ __forceinline__ void gemm_phase(PG8_LAS unsigned char* lds, const Gemm g, const Sched& S, const Epi& E, const int wave_s) {
    int z_ = 0; asm volatile("" : "+s"(z_)); const int lane = __builtin_amdgcn_mbcnt_hi(~0u, __builtin_amdgcn_mbcnt_lo(~0u, z_)), wid = wave_s, tid = wid * 64 + lane, wr = wid >> 2, wc = wid & 3, fr = lane & 15, fq = lane >> 4;
    const int K = g.K;
    unsigned voffA[2], voffB[2];
#pragma unroll
    for (int i = 0; i < 2; ++i) { int R, C; stage_rc(tid * 16 + i * 8192, R, C); const int Rb = Epi::PERM ? ((R & ~31) + perm32(R & 31)) : R;
        voffA[i] = (unsigned)(R * K + C) * 2u; voffB[i] = (unsigned)(Rb * K + C) * 2u; }
    const size_t kstep = (size_t)(BK * 2);
    const size_t hstep = (size_t)HALF * K * 2;
    const size_t tstep = 2 * hstep;
    const unsigned ldsw = (unsigned)wid * 1024u;
    const int aoff = lds_byte(wr * 64 + fr, fq * 8), boff = lds_byte(wc * 32 + fr, fq * 8);
#define PG8_SA(b, h) (((b) * 2 + (h)) * HTB)
#define PG8_SB(b, h) ((4 + (b) * 2 + (h)) * HTB)
#define PG8_STAGE(bufoff, gbase, voff) do { _Pragma("unroll") for (int _i = 0; _i < 2; ++_i) \
        __builtin_amdgcn_global_load_lds((const unsigned*)((const char*)(gbase) + (voff)[_i]), (PG8_LAS unsigned*)(lds + (bufoff) + ldsw + _i * 8192), 16, 0, 0); } while (0)
#define PG8_LDA(dst, b, h) do { _Pragma("unroll") for (int m = 0; m < 4; ++m) _Pragma("unroll") for (int k = 0; k < 2; ++k) dst[m][k] = *(const PG8_LAS bf16x8*)(lds + PG8_SA(b, h) + aoff + m * 2048 + k * 1024); } while (0)
#define PG8_LDB(dst, b, h) do { _Pragma("unroll") for (int n = 0; n < 2; ++n) _Pragma("unroll") for (int k = 0; k < 2; ++k) dst[n][k] = *(const PG8_LAS bf16x8*)(lds + PG8_SB(b, h) + boff + n * 2048 + k * 1024); } while (0)
#define PG8_MMA(ai, bj, At, Bt) do { __builtin_amdgcn_s_setprio(1); _Pragma("unroll") for (int m = 0; m < 4; ++m) _Pragma("unroll") for (int n = 0; n < 2; ++n) _Pragma("unroll") for (int k = 0; k < 2; ++k) \
        acc[ai][bj][m][n] = __builtin_amdgcn_mfma_f32_16x16x32_bf16(Bt[n][k], At[m][k], acc[ai][bj][m][n], 0, 0, 0); __builtin_amdgcn_s_setprio(0); } while (0)
#define PG8_WAIT_V(n) asm volatile("s_waitcnt vmcnt(" #n ")" ::: "memory")
#define PG8_WAIT_L(n) asm volatile("s_waitcnt lgkmcnt(" #n ")" ::: "memory")
#define PG8_BAR __builtin_amdgcn_s_barrier()
#define PG8_SCHED __builtin_amdgcn_sched_barrier(0)
    Unit cur, nxt; int ui = 0;
    if (!S.next(0, cur)) return;
    int nt = cur.nt;
    f32x4 acc[2][2][4][2];
#pragma unroll
    for (int a = 0; a < 2; ++a)
#pragma unroll
        for (int b = 0; b < 2; ++b)
#pragma unroll
            for (int m = 0; m < 4; ++m)
#pragma unroll
                for (int n = 0; n < 2; ++n) acc[a][b][m][n] = (f32x4){0.f, 0.f, 0.f, 0.f};
    bf16x8 At[4][2], B0[2][2], B1[2][2];
    const char* cA = (const char*)g.A + (size_t)cur.pm * tstep + (size_t)cur.k0 * 2; const char* cB = (const char*)g.Bt + (size_t)cur.pn * tstep + (size_t)cur.k0 * 2;
    S.a_ready(cur);
    if constexpr (SP2) {
        PG8_STAGE(PG8_SB(0, 0), cB, voffB); PG8_STAGE(PG8_SB(0, 1), cB + hstep, voffB); PG8_STAGE(PG8_SA(0, 0), cA, voffA); PG8_STAGE(PG8_SA(0, 1), cA + hstep, voffA);
        if (wr == 1) PG8_BAR;
        PG8_WAIT_V(2); PG8_BAR;
        PG8_STAGE(PG8_SB(1, 0), cB + kstep, voffB); PG8_STAGE(PG8_SA(1, 0), cA + kstep, voffA); PG8_STAGE(PG8_SB(1, 1), cB + hstep + kstep, voffB);
        PG8_WAIT_V(6); PG8_BAR;
    } else {
        PG8_STAGE(PG8_SB(0, 0), cB, voffB); PG8_STAGE(PG8_SA(0, 0), cA, voffA); PG8_STAGE(PG8_SB(0, 1), cB + hstep, voffB); PG8_STAGE(PG8_SA(0, 1), cA + hstep, voffA);
        if (wr == 1) PG8_BAR;
        PG8_WAIT_V(4); PG8_BAR;
        PG8_STAGE(PG8_SB(1, 0), cB + kstep, voffB); PG8_STAGE(PG8_SA(1, 0), cA + kstep, voffA); PG8_STAGE(PG8_SB(1, 1), cB + hstep + kstep, voffB);
        PG8_WAIT_V(6); PG8_BAR;
    }
    for (;;) {
        const bool has_next = S.next(ui + 1, nxt);
        const char* nA = has_next ? (const char*)g.A + (size_t)nxt.pm * tstep + (size_t)nxt.k0 * 2 : cA; const char* nB = has_next ? (const char*)g.Bt + (size_t)nxt.pn * tstep + (size_t)nxt.k0 * 2 : cB;
        for (int t = 0; t < nt; t += 2) {
            const bool last = (t == nt - 2);
            const char* a1 = cA + (size_t)(t + 1) * kstep;
            const char* a2 = last ? nA : cA + (size_t)(t + 2) * kstep; const char* b2 = last ? nB : cB + (size_t)(t + 2) * kstep;
            const char* a3 = a2 + kstep; const char* b3 = b2 + kstep;
            if (last && has_next) S.a_ready(nxt);
            if constexpr (SP2) {
            PG8_LDB(B0, 0, 0); PG8_LDB(B1, 0, 1); PG8_SCHED; PG8_LDA(At, 0, 0); PG8_STAGE(PG8_SA(1, 1), a1 + hstep, voffA);
            PG8_WAIT_V(8); PG8_WAIT_L(0); PG8_BAR; PG8_MMA(0, 0, At, B0); PG8_MMA(0, 1, At, B1); PG8_BAR; PG8_SCHED;
            PG8_LDA(At, 0, 1); PG8_STAGE(PG8_SB(0, 0), b2, voffB); PG8_STAGE(PG8_SB(0, 1), b2 + hstep, voffB); PG8_STAGE(PG8_SA(0, 0), a2, voffA);
            PG8_WAIT_V(8); PG8_WAIT_L(0); PG8_BAR; PG8_MMA(1, 0, At, B0); PG8_MMA(1, 1, At, B1); PG8_BAR; PG8_SCHED;
            PG8_LDB(B0, 1, 0); PG8_LDB(B1, 1, 1); PG8_SCHED; PG8_LDA(At, 1, 0); PG8_STAGE(PG8_SA(0, 1), a2 + hstep, voffA);
            PG8_WAIT_V(8); PG8_WAIT_L(0); PG8_BAR; PG8_MMA(0, 0, At, B0); PG8_MMA(0, 1, At, B1); PG8_BAR; PG8_SCHED;
            PG8_LDA(At, 1, 1); PG8_STAGE(PG8_SB(1, 0), b3, voffB); PG8_STAGE(PG8_SB(1, 1), b3 + hstep, voffB); PG8_STAGE(PG8_SA(1, 0), a3, voffA);
            PG8_WAIT_V(8); PG8_WAIT_L(0); PG8_BAR; PG8_MMA(1, 0, At, B0); PG8_MMA(1, 1, At, B1); PG8_BAR; PG8_SCHED;
            } else {
            PG8_LDB(B0, 0, 0); PG8_SCHED; PG8_LDA(At, 0, 0); PG8_STAGE(PG8_SA(1, 1), a1 + hstep, voffA);
            PG8_WAIT_L(8); PG8_BAR; PG8_WAIT_L(0); PG8_MMA(0, 0, At, B0); PG8_BAR; PG8_SCHED;
            PG8_LDB(B1, 0, 1); PG8_STAGE(PG8_SB(0, 0), b2, voffB);
            PG8_BAR; PG8_WAIT_L(0); PG8_MMA(0, 1, At, B1); PG8_BAR;
            PG8_LDA(At, 0, 1); PG8_STAGE(PG8_SA(0, 0), a2, voffA);
            PG8_BAR; PG8_WAIT_L(0); PG8_MMA(1, 0, At, B0); PG8_BAR; PG8_SCHED;
            PG8_STAGE(PG8_SB(0, 1), b2 + hstep, voffB);
            PG8_WAIT_V(6); PG8_BAR; PG8_MMA(1, 1, At, B1); PG8_BAR;
            PG8_LDB(B0, 1, 0); PG8_SCHED; PG8_LDA(At, 1, 0); PG8_STAGE(PG8_SA(0, 1), a2 + hstep, voffA);
            PG8_WAIT_L(8); PG8_BAR; PG8_WAIT_L(0); PG8_MMA(0, 0, At, B0); PG8_BAR; PG8_SCHED;
            PG8_LDB(B1, 1, 1); PG8_STAGE(PG8_SB(1, 0), b3, voffB);
            PG8_BAR; PG8_WAIT_L(0); PG8_MMA(0, 1, At, B1); PG8_BAR;
            PG8_LDA(At, 1, 1); PG8_STAGE(PG8_SA(1, 0), a3, voffA);
            PG8_BAR; PG8_WAIT_L(0); PG8_MMA(1, 0, At, B0); PG8_BAR; PG8_SCHED;
            PG8_STAGE(PG8_SB(1, 1), b3 + hstep, voffB);
            PG8_WAIT_V(6); PG8_BAR; PG8_MMA(1, 1, At, B1); PG8_BAR;
            }
        }
        if constexpr (ALIGN_EPI) { if (wr == 0) PG8_BAR; }
        if constexpr (!Epi::AFTER_DRAIN) { E(acc, cur, wr, wc, fr, fq); S.done(cur); }
        if (!has_next) break;
#pragma unroll
        for (int a = 0; a < 2; ++a)
#pragma unroll
            for (int b = 0; b < 2; ++b)
#pragma unroll
                for (int m = 0; m < 4; ++m)
#pragma unroll
                    for (int n = 0; n < 2; ++n) acc[a][b][m][n] = (f32x4){0.f, 0.f, 0.f, 0.f};
        cur = nxt; cA = nA; cB = nB; nt = cur.nt; ++ui;
        if constexpr (ALIGN_EPI) { if (wr == 1) PG8_BAR; }
    }
    PG8_WAIT_V(0);
    if constexpr (!ALIGN_EPI) { if (wr == 0) PG8_BAR; }
    PG8_BAR;
    if constexpr (Epi::AFTER_DRAIN) { E.fused(acc, cur, wr, wc, fr, fq, lds, wid, lane); S.done(cur); }
#undef PG8_SA
#undef PG8_SB
#undef PG8_STAGE
#undef PG8_LDA
#undef PG8_LDB
#undef PG8_MMA
#undef PG8_WAIT_V
#undef PG8_WAIT_L
#undef PG8_BAR
#undef PG8_SCHED
}
}

#define LAS __attribute__((address_space(3)))
typedef unsigned short bf16_t;
typedef short bf16x8 __attribute__((ext_vector_type(8)));
typedef short bf16x4 __attribute__((ext_vector_type(4)));
typedef float f32x4 __attribute__((ext_vector_type(4)));
typedef float f32x2 __attribute__((ext_vector_type(2)));
typedef float f32x16 __attribute__((ext_vector_type(16)));
typedef unsigned u32x4 __attribute__((ext_vector_type(4)));
typedef unsigned u32x2 __attribute__((ext_vector_type(2)));

constexpr int DM = 1024, NB = 4, SEQ = 4096, CTXL = 256, ML = NB * SEQ, MC = NB * CTXL, MT = ML + MC;
constexpr int DFF = 2816, NGU = 2 * DFF, EVIN = 1280, ODIN = 3072, KOUT0 = 1536;
constexpr int NWAVES = 8, NTHR = 512;
constexpr size_t MiB = 1u << 20;
constexpr size_t WS_MOD = 65536, WS_ROPE = 320 * 1024, WS_GAM = 384 * 1024, WS_RSS = 448 * 1024, WS_BIAS = 704 * 1024;
constexpr size_t WS_WIN0 = 1 * MiB, WS_WOUT0 = WS_WIN0 + (size_t)EVIN * DM * 2, WS_WGU0 = WS_WOUT0 + (size_t)DM * KOUT0 * 2, WS_WD0 = WS_WGU0 + (size_t)NGU * DM * 2;
constexpr size_t WS_WIN1 = WS_WD0 + (size_t)DM * DFF * 2, WS_WOUT1 = WS_WIN1 + (size_t)ODIN * DM * 2, WS_WGU1 = WS_WOUT1 + (size_t)DM * DM * 2, WS_WD1 = WS_WGU1 + (size_t)NGU * DM * 2;
constexpr size_t WS_WEND = WS_WD1 + (size_t)DM * DFF * 2;
constexpr size_t WS_XS = 48 * MiB, WS_XN = 116 * MiB, WS_BIG = 150 * MiB, WS_END = 252 * MiB;
constexpr size_t WS_T0 = WS_BIG, WS_A20 = WS_BIG + 43 * MiB;
static_assert(WS_WEND <= WS_XS, "weights");
static_assert(WS_XS + (size_t)MT * DM * 4 <= WS_XN && WS_XN + (size_t)MT * DM * 2 <= WS_BIG, "ws map");
static_assert(WS_T0 + (size_t)MT * EVIN * 2 <= WS_A20 && WS_A20 + (size_t)MT * KOUT0 * 2 <= WS_END && WS_BIG + (size_t)MT * ODIN * 2 <= WS_END && WS_BIG + (size_t)MT * DFF * 2 <= WS_END, "big region");
constexpr int LDS_BYTES = 155648;

struct Params {
    const float *x, *c, *ctx, *c_ctx, *ada_w, *ada_b, *norm1_g, *norm2_g, *w_gate, *w_up, *w_down, *ev_w_in, *ev_w_out, *ev_qn, *ev_kn, *ev_sink, *od_w_in, *od_w_out, *od_qn, *od_kn, *od_rb;
    float* out; unsigned char* ws;
};

__device__ __forceinline__ unsigned pk2(float lo, float hi) { typedef __bf16 bfx2 __attribute__((ext_vector_type(2))); f32x2 v = {lo, hi}; bfx2 b = __builtin_convertvector(v, bfx2); return __builtin_bit_cast(unsigned, b); }
__device__ __forceinline__ float bflo(unsigned w) { return __uint_as_float(w << 16); }
__device__ __forceinline__ float bfhi(unsigned w) { return __uint_as_float(w & 0xffff0000u); }
template <int K> __device__ __forceinline__ float swz_xor(float v) { return __int_as_float(__builtin_amdgcn_ds_swizzle(__float_as_int(v), (K << 10) | 0x1F)); }
__device__ __forceinline__ float xor32(float v, int lane) { return __int_as_float(__builtin_amdgcn_ds_bpermute((lane ^ 32) << 2, __float_as_int(v))); }
__device__ __forceinline__ float wave_sum(float v, int lane) {
    v += swz_xor<1>(v); v += swz_xor<2>(v); v += swz_xor<4>(v); v += swz_xor<8>(v); v += swz_xor<16>(v); v += xor32(v, lane);
    return v;
}
__device__ __forceinline__ float cos_rev(float r) { return __builtin_amdgcn_cosf(r); }
__device__ __forceinline__ float sin_rev(float r) { return __builtin_amdgcn_sinf(r); }

__device__ __forceinline__ int gu_row(int F, int isup) { return (F >> 7) * 256 + ((F >> 2) & 1) * 128 + ((F >> 5) & 3) * 32 + ((F >> 3) & 3) * 8 + isup * 4 + (F & 3); }
struct TDesc { const float* W; int N; bf16_t* WT; int ldk, koff, mode, item; };
__device__ __forceinline__ void tr_load(const TDesc& d, f32x4 (&v)[8], int tid) {
    const int nblk = d.N / 128, kb = d.item / nblk, nb = d.item % nblk, k0 = 128 * kb, n0 = 128 * nb; const int r = tid >> 5, c4 = tid & 31;
#pragma unroll
    for (int p = 0; p < 8; ++p) v[p] = *(const f32x4*)(d.W + (size_t)(k0 + r + 16 * p) * d.N + n0 + 4 * c4);
}
__device__ __forceinline__ void tr_stage(const f32x4 (&v)[8], LAS float* tile, int tid) {
    const int r = tid >> 5, c4 = tid & 31;
#pragma unroll
    for (int p = 0; p < 8; ++p) { LAS float* dd = tile + (r + 16 * p) * 129 + 4 * c4; dd[0] = v[p].x; dd[1] = v[p].y; dd[2] = v[p].z; dd[3] = v[p].w; }
}
__device__ __forceinline__ void tr_store(const TDesc& d, const LAS float* tile, int tid) {
    const int nblk = d.N / 128, kb = d.item / nblk, nb = d.item % nblk, k0 = 128 * kb, n0 = 128 * nb; const int c = tid & 7, nl = tid >> 3;
#pragma unroll
    for (int p = 0; p < 4; ++p) { const int n = nl + 64 * (p & 1), q = c + 8 * (p >> 1); const LAS float* s = tile + (8 * q) * 129 + n;
        u32x4 o; o.x = pk2(s[0 * 129], s[1 * 129]); o.y = pk2(s[2 * 129], s[3 * 129]); o.z = pk2(s[4 * 129], s[5 * 129]); o.w = pk2(s[6 * 129], s[7 * 129]);
        const int nn = n0 + n; const int row = d.mode == 0 ? nn : gu_row(nn, d.mode - 1);
        *(u32x4*)(d.WT + (size_t)row * d.ldk + d.koff + k0 + 8 * q) = o; }
}
__device__ __forceinline__ TDesc tdesc0(int r, const float* ev_in, const float* ev_out, const float* wg, const float* wu, const float* wd, unsigned char* ws) {
    constexpr int I_IN0 = 8 * (EVIN / 128), I_OUT0 = 4 * 8, I_G = 8 * (DFF / 128);
    if (r < I_IN0) return TDesc{ev_in, EVIN, (bf16_t*)(ws + WS_WIN0), DM, 0, 0, r}; r -= I_IN0;
    if (r < I_OUT0) return TDesc{ev_out + (size_t)512 * DM, DM, (bf16_t*)(ws + WS_WOUT0), KOUT0, 1024, 0, r}; r -= I_OUT0;
    if (r < I_G) return TDesc{wg, DFF, (bf16_t*)(ws + WS_WGU0), DM, 0, 1, r}; r -= I_G;
    if (r < I_G) return TDesc{wu, DFF, (bf16_t*)(ws + WS_WGU0), DM, 0, 2, r}; r -= I_G;
    return TDesc{wd, DM, (bf16_t*)(ws + WS_WD0), DFF, 0, 0, r};
}
__device__ __forceinline__ TDesc tdesc1(int r, const float* od_in, const float* od_out, const float* wg, const float* wu, const float* wd, unsigned char* ws) {
    constexpr int I_IN1 = 8 * (ODIN / 128), I_OUT1 = 8 * 8, I_G = 8 * (DFF / 128);
    if (r < I_IN1) return TDesc{od_in, ODIN, (bf16_t*)(ws + WS_WIN1), DM, 0, 0, r}; r -= I_IN1;
    if (r < I_OUT1) return TDesc{od_out, DM, (bf16_t*)(ws + WS_WOUT1), DM, 0, 0, r}; r -= I_OUT1;
    if (r < I_G) return TDesc{wg + (size_t)DM * DFF, DFF, (bf16_t*)(ws + WS_WGU1), DM, 0, 1, r}; r -= I_G;
    if (r < I_G) return TDesc{wu + (size_t)DM * DFF, DFF, (bf16_t*)(ws + WS_WGU1), DM, 0, 2, r}; r -= I_G;
    return TDesc{wd + (size_t)DFF * DM, DM, (bf16_t*)(ws + WS_WD1), DFF, 0, 0, r};
}
__device__ __forceinline__ void fourier_w_item(LAS unsigned char* lds, const float* w_out, bf16_t* WOUT0, int item, int tid) {
    const int g = item >> 6, n0 = (item & 63) * 16;
    LAS float* w = (LAS float*)lds; LAS f32x2* tab = (LAS f32x2*)(lds + 8192);
    for (int i = tid; i < 128 * 16; i += NTHR) w[i] = w_out[(size_t)(g * 128 + (i >> 4)) * 1024 + n0 + (i & 15)];
    if (tid < 128) { const float r = (float)tid * (1.0f / 128.0f); tab[tid] = (f32x2){cos_rev(r), sin_rev(r)}; }
    __syncthreads();
    const int nl = tid & 15, cg4 = (tid >> 4) * 4;
    float aC[4] = {0.f, 0.f, 0.f, 0.f}, aS[4] = {0.f, 0.f, 0.f, 0.f};
#pragma unroll 4
    for (int m = 0; m < 128; ++m) { const float xv = w[m * 16 + nl];
#pragma unroll
        for (int ci = 0; ci < 4; ++ci) { const f32x2 cs = tab[((cg4 + ci) * m) & 127]; aC[ci] += cs.x * xv; aS[ci] += cs.y * xv; } }
    const float s = 0.08838834764831845f;
    bf16_t* dst = WOUT0 + (size_t)(n0 + nl) * KOUT0 + g * 128 + cg4;
    u32x2 o; o.x = pk2(aC[0] * s, aC[1] * s); o.y = pk2(aC[2] * s, aC[3] * s); *(u32x2*)dst = o;
    o.x = pk2(aS[0] * s, aS[1] * s); o.y = pk2(aS[2] * s, aS[3] * s); *(u32x2*)(dst + 512) = o;
    __syncthreads();
}
__device__ __forceinline__ void adaln_unit(LAS unsigned char* lds, const float* c, const float* c_ctx, const float* ada_w, const float* ada_b, float* mod, int unit, int tid) {
    const int layer = unit / 48, n0 = (unit % 48) * 128;
    LAS float* sv = (LAS float*)lds; LAS f32x4* red = (LAS f32x4*)(lds + 20480);
#pragma unroll
    for (int hb = 0; hb < 2; ++hb) { float xin[5];
#pragma unroll
      for (int q = 0; q < 5; ++q) { const int i = tid + (5 * hb + q) * NTHR, v = __builtin_amdgcn_readfirstlane(i >> 10), k = i & 1023; const float* src = v < 4 ? c + v * 1024 : c_ctx; xin[q] = src[k]; }
#pragma unroll
      for (int q = 0; q < 5; ++q) { const float xv = xin[q]; sv[tid + (5 * hb + q) * NTHR] = xv * __builtin_amdgcn_rcpf(1.0f + __builtin_amdgcn_exp2f(-1.4426950408889634f * xv)); } }
    __syncthreads();
    const int cg = tid & 31, kc = tid >> 5;
    f32x4 acc[5];
#pragma unroll
    for (int v = 0; v < 5; ++v) acc[v] = (f32x4){0.f, 0.f, 0.f, 0.f};
    const float* wp = ada_w + (size_t)layer * 1024 * 6144 + (size_t)(kc * 64) * 6144 + n0 + 4 * cg;
#pragma unroll 16
    for (int kk = 0; kk < 64; ++kk) { const f32x4 wv = *(const f32x4*)(wp + (size_t)kk * 6144);
#pragma unroll
        for (int v = 0; v < 5; ++v) acc[v] += wv * sv[v * 1024 + kc * 64 + kk]; }
#pragma unroll
    for (int v = 0; v < 5; ++v) red[(kc * 5 + v) * 32 + cg] = acc[v];
    __syncthreads();
    if (tid < 160) { const int v = tid >> 5; f32x4 s = *(const f32x4*)(ada_b + layer * 6144 + n0 + 4 * cg);
#pragma unroll
        for (int k2 = 0; k2 < 16; ++k2) s += red[(k2 * 5 + v) * 32 + cg];
        *(f32x4*)(mod + (size_t)(layer * 5 + v) * 6144 + n0 + 4 * cg) = s; }
    __syncthreads();
}
__device__ __forceinline__ void bias_rows(const bf16_t* Bt, int nrows, const float* shift  , float* bias, int gw, int ngw, int lane) {
    for (int n0 = 4 * gw; n0 < nrows; n0 += 4 * ngw) {
        u32x4 w[4][2]; f32x4 sv[5][4];
#pragma unroll
        for (int r = 0; r < 4; ++r) { w[r][0] = *(const u32x4*)(Bt + (size_t)(n0 + r) * DM + 16 * lane); w[r][1] = *(const u32x4*)(Bt + (size_t)(n0 + r) * DM + 16 * lane + 8); }
#pragma unroll
        for (int v = 0; v < 5; ++v)
#pragma unroll
            for (int q = 0; q < 4; ++q) sv[v][q] = *(const f32x4*)(shift + (size_t)v * 6144 + 16 * lane + 4 * q);
        float res[5][4];
#pragma unroll
        for (int v = 0; v < 5; ++v)
#pragma unroll
            for (int r = 0; r < 4; ++r) { const u32x4 a = w[r][0], c = w[r][1];
                float d = (bflo(a.x) * sv[v][0].x + bfhi(a.x) * sv[v][0].y) + (bflo(a.y) * sv[v][0].z + bfhi(a.y) * sv[v][0].w);
                d += (bflo(a.z) * sv[v][1].x + bfhi(a.z) * sv[v][1].y) + (bflo(a.w) * sv[v][1].z + bfhi(a.w) * sv[v][1].w);
                d += (bflo(c.x) * sv[v][2].x + bfhi(c.x) * sv[v][2].y) + (bflo(c.y) * sv[v][2].z + bfhi(c.y) * sv[v][2].w);
                d += (bflo(c.z) * sv[v][3].x + bfhi(c.z) * sv[v][3].y) + (bflo(c.w) * sv[v][3].z + bfhi(c.w) * sv[v][3].w);
                res[v][r] = wave_sum(d, lane); }
        if (lane == 0) {
#pragma unroll
            for (int v = 0; v < 5; ++v) *(f32x4*)(bias + (size_t)v * nrows + n0) = (f32x4){res[v][0], res[v][1], res[v][2], res[v][3]}; }
    }
}
__device__ __forceinline__ void rms_mod_rows(const float* src_lat, const float* src_ctx, int nrows, const float* g, const float* modl, int sh_off, int sc_off, bf16_t* XN, int gw, int ngw, int lane) {
    for (int row0 = gw; row0 < nrows; row0 += 2 * ngw) {
        const int row1 = row0 + ngw; const bool has1 = row1 < nrows; const int rows[2] = {row0, has1 ? row1 : row0};
        f32x4 v[2][4]; float ss[2] = {0.f, 0.f};
#pragma unroll
        for (int t = 0; t < 2; ++t) { const int row = rows[t]; const float* xr = row >= ML ? src_ctx + (size_t)(row - ML) * DM : src_lat + (size_t)row * DM;
#pragma unroll
            for (int j = 0; j < 4; ++j) v[t][j] = *(const f32x4*)(xr + 4 * lane + 256 * j); }
#pragma unroll
        for (int t = 0; t < 2; ++t)
#pragma unroll
            for (int j = 0; j < 4; ++j) ss[t] += (v[t][j].x * v[t][j].x + v[t][j].y * v[t][j].y) + (v[t][j].z * v[t][j].z + v[t][j].w * v[t][j].w);
#pragma unroll
        for (int t = 0; t < 2; ++t) { if (t == 1 && !has1) break; const int row = rows[t]; const int bidx = row >= ML ? 4 : (row >> 12);
            const float rstd = __builtin_amdgcn_rsqf(wave_sum(ss[t], lane) * (1.0f / DM) + 1e-6f);
            const float* mb = modl + (size_t)bidx * 6144;
#pragma unroll
            for (int j = 0; j < 4; ++j) { const int col = 4 * lane + 256 * j;
                const f32x4 gg = *(const f32x4*)(g + col), sc = *(const f32x4*)(mb + sc_off + col), sh = *(const f32x4*)(mb + sh_off + col);
                const f32x4 y = (v[t][j] * rstd) * gg * (sc + 1.0f) + sh;
                u32x2 w; w.x = pk2(y.x, y.y); w.y = pk2(y.z, y.w);
                *(u32x2*)(XN + (size_t)row * DM + col) = w; } }
    }
}

constexpr float SC_L2 = 0.125f * 1.4426950408889634f, LOG2E = 1.4426950408889634f, NEGBIG = -1e30f;
template <int LAYER>
__device__ __forceinline__ void post_unit(const pg8::Unit u, bf16_t* T, const float* qg, const float* kg, const float* rope, bf16_t* KF, bf16_t* KFC, bf16_t* VF, bf16_t* VFC, LAS unsigned char* vlds, int tid) {
    constexpr int LDT = LAYER == 0 ? EVIN : ODIN, NH = LAYER == 0 ? 2 : 16;
    const int rowbase = u.pm * 256; const bool isctx = rowbase >= ML;
    const int bb = isctx ? ((rowbase - ML) >> 8) : (rowbase >> 12); const int posbase = isctx ? 0 : (rowbase & 4095); const int nkb = isctx ? 8 : 128;
#pragma unroll 1
    for (int gi = 0; gi < 4; ++gi) {
        const int cgp = 4 * u.pn + gi; int kind, h;
        if (LAYER == 0) { if (cgp < 8) { kind = 0; h = 0; } else if (cgp < 16) { kind = 1; h = cgp - 8; } else if (cgp < 18) { kind = 2; h = cgp - 16; } else { kind = 3; h = cgp - 18; } }
        else { if (cgp < 16) { kind = 1; h = cgp; } else if (cgp < 32) { kind = 2; h = cgp - 16; } else { kind = 3; h = cgp - 32; } }
        if (kind == 0) continue;
        const int bh = bb * NH + h;
        u32x4 vin[4];
        if (kind == 3) {
            bf16_t* vdst = isctx ? VFC : VF; LAS bf16_t* vt = (LAS bf16_t*)vlds; constexpr int VP = 264;
#pragma unroll
            for (int pass = 0; pass < 4; ++pass) { const int idx = pass * NTHR + tid, rl = idx & 255, ch = idx >> 8; vin[pass] = *(const u32x4*)(T + (size_t)(rowbase + rl) * LDT + 64 * cgp + 8 * ch); }
#pragma unroll
            for (int pass = 0; pass < 4; ++pass) { const int idx = pass * NTHR + tid, rl = idx & 255, ch = idx >> 8; const u32x4 v = vin[pass]; LAS bf16_t* d0 = vt + (8 * ch) * VP + rl;
                d0[0 * VP] = (bf16_t)(v.x & 0xffffu); d0[1 * VP] = (bf16_t)(v.x >> 16); d0[2 * VP] = (bf16_t)(v.y & 0xffffu); d0[3 * VP] = (bf16_t)(v.y >> 16);
                d0[4 * VP] = (bf16_t)(v.z & 0xffffu); d0[5 * VP] = (bf16_t)(v.z >> 16); d0[6 * VP] = (bf16_t)(v.w & 0xffffu); d0[7 * VP] = (bf16_t)(v.w >> 16); }
            __syncthreads();
#pragma unroll
            for (int i = 0; i < 4; ++i) { const int f = tid + NTHR * i, kb = f >> 8, sp = (f >> 7) & 1, db = (f >> 6) & 1, ln = f & 63, d = 32 * db + (ln & 31), key0 = 32 * kb + 16 * sp + 4 * (ln >> 5);
                const u32x2 lo = *(const LAS u32x2*)(vt + d * VP + key0), hi4 = *(const LAS u32x2*)(vt + d * VP + key0 + 8);
                const u32x4 o = {lo.x, lo.y, hi4.x, hi4.y};
                *(u32x4*)(vdst + ((((size_t)(bh * nkb + (posbase >> 5) + kb) * 2 + sp) * 2 + db) * 64 + ln) * 8) = o; }
            __syncthreads();
            continue;
        }
        const float* gam = kind == 1 ? qg : kg; const float osc = kind == 1 ? SC_L2 : 1.0f;
        bf16_t* kdst = isctx ? KFC : KF;
#pragma unroll
        for (int pass = 0; pass < 4; ++pass) { const int idx = pass * NTHR + tid, rl = idx >> 3, ch = idx & 7; vin[pass] = *(const u32x4*)(T + (size_t)(rowbase + rl) * LDT + 64 * cgp + 8 * ch); }
        const int chl = tid & 7;
        const f32x4 g0 = *(const f32x4*)(gam + 8 * chl), g1 = *(const f32x4*)(gam + 8 * chl + 4);
        const float gg[8] = {g0.x, g0.y, g0.z, g0.w, g1.x, g1.y, g1.z, g1.w};
#pragma unroll
        for (int pass = 0; pass < 4; ++pass) { const int idx = pass * NTHR + tid, rl = idx >> 3, ch = idx & 7; const int row = rowbase + rl;
            bf16_t* ptr = T + (size_t)row * LDT + 64 * cgp + 8 * ch;
            const u32x4 v = vin[pass];
            float xv[8] = {bflo(v.x), bfhi(v.x), bflo(v.y), bfhi(v.y), bflo(v.z), bfhi(v.z), bflo(v.w), bfhi(v.w)};
            float ss = 0.f;
#pragma unroll
            for (int j = 0; j < 8; ++j) ss += xv[j] * xv[j];
            ss += swz_xor<1>(ss); ss += swz_xor<2>(ss); ss += swz_xor<4>(ss);
            const float rstd = __builtin_amdgcn_rsqf(ss * (1.0f / 64.0f) + 1e-6f) * osc;
#pragma unroll
            for (int j = 0; j < 8; ++j) xv[j] = xv[j] * rstd * gg[j];
            if (LAYER == 0 && !isctx) {
                const int pos = row & 4095; const int coord = (ch >= 4) ? (pos & 63) : (pos >> 6);
                const float* tb = rope + (size_t)(coord * 16 + 8 * (ch & 1)) * 2; const bool second = (ch >> 1) & 1;
                f32x4 cs4[4];
#pragma unroll
                for (int j = 0; j < 4; ++j) cs4[j] = *(const f32x4*)(tb + 4 * j);
#pragma unroll
                for (int j = 0; j < 8; ++j) { const float px = swz_xor<2>(xv[j]); const float c = cs4[j >> 1][2 * (j & 1)], sn = cs4[j >> 1][2 * (j & 1) + 1];
                    xv[j] = second ? (xv[j] * c + px * sn) : (xv[j] * c - px * sn); }
            }
            u32x4 o; o.x = pk2(xv[0], xv[1]); o.y = pk2(xv[2], xv[3]); o.z = pk2(xv[4], xv[5]); o.w = pk2(xv[6], xv[7]);
            if (kind == 1) *(u32x4*)ptr = o;
            else { const int pos = posbase + rl; *(u32x4*)(kdst + (((size_t)(bh * nkb + (pos >> 5)) * 4 + (ch >> 1)) * 64 + (pos & 31) + 32 * (ch & 1)) * 8) = o; } }
    }
}

#define CMUL(a, c, s) do { const float _x = (a).x * (c) - (a).y * (s); (a).y = (a).x * (s) + (a).y * (c); (a).x = _x; } while (0)
#define FFT2(a, b) do { const f32x2 _t = (a); (a) = _t + (b); (b) = _t - (b); } while (0)
#define MULNI(a) do { const float _x = (a).y; (a).y = -(a).x; (a).x = _x; } while (0)
__device__ __forceinline__ void fft8(f32x2 (&u)[8]) {
    const float h = 0.70710678118654752f;
    FFT2(u[0], u[4]); FFT2(u[1], u[5]); FFT2(u[2], u[6]); FFT2(u[3], u[7]);
    CMUL(u[5], h, -h); MULNI(u[6]); CMUL(u[7], -h, -h);
    FFT2(u[0], u[2]); FFT2(u[1], u[3]); FFT2(u[4], u[6]); FFT2(u[5], u[7]);
    MULNI(u[3]); MULNI(u[7]);
    FFT2(u[0], u[1]); FFT2(u[2], u[3]); FFT2(u[4], u[5]); FFT2(u[6], u[7]);
}
__device__ __forceinline__ void fft_slab(LAS unsigned char* lds, const bf16_t* T0, bf16_t* A2, int slab, int tid) {
    LAS f32x2* buf = (LAS f32x2*)lds;
#define FI(f, i) ((f) * 4608 + (i) + ((i) >> 3))
    const int b = slab >> 6, ch0 = (slab & 63) * 8;
#pragma unroll
    for (int t = 0; t < 8; ++t) { const int l = tid + NTHR * t; const u32x4 v = *(const u32x4*)(T0 + (size_t)(b * SEQ + l) * EVIN + ch0);
        buf[FI(0, l)] = (f32x2){bflo(v.x), bfhi(v.x)}; buf[FI(1, l)] = (f32x2){bflo(v.y), bfhi(v.y)}; buf[FI(2, l)] = (f32x2){bflo(v.z), bfhi(v.z)}; buf[FI(3, l)] = (f32x2){bflo(v.w), bfhi(v.w)}; }
    __syncthreads();
#pragma unroll 1
    for (int p = 1; p < 4096; p <<= 3) {
        f32x2 u[4][8]; const int k = tid & (p - 1);
#pragma unroll
        for (int f = 0; f < 4; ++f)
#pragma unroll
            for (int t = 0; t < 8; ++t) u[f][t] = buf[FI(f, tid + NTHR * t)];
        if (p > 1) { const float inv = 1.0f / (float)(8 * p);
#pragma unroll
            for (int t = 1; t < 8; ++t) { const float r = (float)(k * t) * inv; const float c = cos_rev(r), s = -sin_rev(r);
#pragma unroll
                for (int f = 0; f < 4; ++f) CMUL(u[f][t], c, s); } }
#pragma unroll
        for (int f = 0; f < 4; ++f) fft8(u[f]);
        __syncthreads();
        const int j = ((tid - k) << 3) + k;
#pragma unroll
        for (int f = 0; f < 4; ++f) {
            buf[FI(f, j)] = u[f][0]; buf[FI(f, j + p)] = u[f][4]; buf[FI(f, j + 2 * p)] = u[f][2]; buf[FI(f, j + 3 * p)] = u[f][6]; buf[FI(f, j + 4 * p)] = u[f][1]; buf[FI(f, j + 5 * p)] = u[f][5]; buf[FI(f, j + 6 * p)] = u[f][3]; buf[FI(f, j + 7 * p)] = u[f][7]; }
        __syncthreads();
    }
    const float sc = 0.5f / 64.0f;
#pragma unroll 2
    for (int t = 0; t < 8; ++t) { const int k = tid + NTHR * t, kn = (4096 - k) & 4095; float re[8], im[8];
#pragma unroll
        for (int f = 0; f < 4; ++f) { const f32x2 Z = buf[FI(f, k)], W = buf[FI(f, kn)];
            re[2 * f] = (Z.x + W.x) * sc; im[2 * f] = (Z.y - W.y) * sc; re[2 * f + 1] = (Z.y + W.y) * sc; im[2 * f + 1] = (W.x - Z.x) * sc; }
        bf16_t* o = A2 + (size_t)(b * SEQ + k) * KOUT0 + ch0;
        u32x4 w; w.x = pk2(re[0], re[1]); w.y = pk2(re[2], re[3]); w.z = pk2(re[4], re[5]); w.w = pk2(re[6], re[7]); *(u32x4*)o = w;
        w.x = pk2(im[0], im[1]); w.y = pk2(im[2], im[3]); w.z = pk2(im[4], im[5]); w.w = pk2(im[6], im[7]); *(u32x4*)(o + 512) = w; }
    __syncthreads();
#undef FI
}
__device__ __forceinline__ void ctxdft_slab(LAS unsigned char* lds, const bf16_t* T0, bf16_t* A2, int slab, int tid) {
    const int b = slab >> 6, ch0 = (slab & 63) * 8;
    LAS float* xs = (LAS float*)lds; LAS f32x2* tab = (LAS f32x2*)(lds + 8192);
    if (tid < 256) { const u32x4 v = *(const u32x4*)(T0 + (size_t)(ML + b * CTXL + tid) * EVIN + ch0);
        LAS float* d = xs + tid * 8; d[0] = bflo(v.x); d[1] = bfhi(v.x); d[2] = bflo(v.y); d[3] = bfhi(v.y); d[4] = bflo(v.z); d[5] = bfhi(v.z); d[6] = bflo(v.w); d[7] = bfhi(v.w);
        const float r = (float)tid * (1.0f / 256.0f); tab[tid] = (f32x2){cos_rev(r), sin_rev(r)}; }
    __syncthreads();
    const int k = tid >> 1, hf = tid & 1;
    f32x4 re = {0.f, 0.f, 0.f, 0.f}, im = {0.f, 0.f, 0.f, 0.f};
#pragma unroll 4
    for (int l = 0; l < 256; ++l) { const f32x2 cs = tab[(k * l) & 255]; const f32x4 xv = *(const LAS f32x4*)(xs + l * 8 + 4 * hf); re += xv * cs.x; im -= xv * cs.y; }
    re *= (1.0f / 16.0f); im *= (1.0f / 16.0f);
    bf16_t* o = A2 + (size_t)(ML + b * CTXL + k) * KOUT0 + ch0 + 4 * hf;
    u32x2 w; w.x = pk2(re.x, re.y); w.y = pk2(re.z, re.w); *(u32x2*)o = w;
    w.x = pk2(im.x, im.y); w.y = pk2(im.z, im.w); *(u32x2*)(o + 512) = w;
    __syncthreads();
}

struct QTile { f32x16 o0, o1; float l; };
__device__ __forceinline__ void tile_init(QTile& t, float l0) {
#pragma unroll
    for (int i = 0; i < 16; ++i) { t.o0[i] = 0.f; t.o1[i] = 0.f; }
    t.l = l0; }
__device__ __forceinline__ float wave_max(float v, int lane) {
    v = fmaxf(v, swz_xor<1>(v)); v = fmaxf(v, swz_xor<2>(v)); v = fmaxf(v, swz_xor<4>(v)); v = fmaxf(v, swz_xor<8>(v)); v = fmaxf(v, swz_xor<16>(v)); v = fmaxf(v, xor32(v, lane));
    return v; }
struct NoMask { __device__ __forceinline__ void operator()(f32x16&) const {} };
struct WinMask { int ql, hi; bool first;
    __device__ __forceinline__ void operator()(f32x16& s) const {
#pragma unroll
        for (int i = 0; i < 16; ++i) { const int cr = (i & 3) + 8 * (i >> 2) + 4 * hi; const bool ok = first ? (cr >= ql) : (cr <= ql); s[i] = ok ? s[i] : NEGBIG; } } };
struct NaMask { const LAS float* tb; int bm;
    __device__ __forceinline__ void operator()(f32x16& s) const {
#pragma unroll
        for (int i = 0; i < 16; ++i) { const int off = (i & 3) + 8 * (i >> 2); const float bv = tb[off]; const bool ok = (unsigned)(bm + off) < 16u; const float sv = s[i] + bv; s[i] = ok ? sv : NEGBIG; } } };
__device__ __forceinline__ void tile_update(QTile& T, const f32x16& s, const bf16x8 (&vf)[4]) {
    float ps = 0.f; unsigned pk[8];
#pragma unroll
    for (int i = 0; i < 16; i += 2) { const float p0 = __builtin_amdgcn_exp2f(s[i]), p1 = __builtin_amdgcn_exp2f(s[i + 1]); ps += p0 + p1; pk[i >> 1] = pk2(p0, p1); }
    T.l += ps;
    const u32x4 pw0 = {pk[0], pk[1], pk[2], pk[3]}, pw1 = {pk[4], pk[5], pk[6], pk[7]};
    const bf16x8 pf0 = __builtin_bit_cast(bf16x8, pw0), pf1 = __builtin_bit_cast(bf16x8, pw1);
    T.o0 = __builtin_amdgcn_mfma_f32_32x32x16_bf16(vf[0], pf0, T.o0, 0, 0, 0); T.o1 = __builtin_amdgcn_mfma_f32_32x32x16_bf16(vf[1], pf0, T.o1, 0, 0, 0);
    T.o0 = __builtin_amdgcn_mfma_f32_32x32x16_bf16(vf[2], pf1, T.o0, 0, 0, 0); T.o1 = __builtin_amdgcn_mfma_f32_32x32x16_bf16(vf[3], pf1, T.o1, 0, 0, 0);
}
__device__ __forceinline__ void ld_frag(bf16x8 (&f)[4], const bf16_t* blk, int lane) {
#pragma unroll
    for (int t = 0; t < 4; ++t) f[t] = *(const bf16x8*)(blk + t * 512 + lane * 8); }
template <class MA, class MB>
__device__ __forceinline__ void attn_step(QTile& A, QTile& B, const bf16x8 (&qa)[4], const bf16x8 (&qb)[4], bf16x8 (&kf)[4], const bf16x8 (&vf)[4], const MA& ma, const MB& mb, const bool active, const float negm0, int lane, const bf16_t* knext) {
    f32x16 s;
#pragma unroll
    for (int i = 0; i < 16; ++i) s[i] = negm0;
#pragma unroll
    for (int t = 0; t < 4; ++t) s = __builtin_amdgcn_mfma_f32_32x32x16_bf16(kf[t], qa[t], s, 0, 0, 0);
    if (active) ma(s);
    tile_update(A, s, vf);
    __builtin_amdgcn_sched_barrier(0);
#pragma unroll
    for (int i = 0; i < 16; ++i) s[i] = negm0;
#pragma unroll
    for (int t = 0; t < 4; ++t) s = __builtin_amdgcn_mfma_f32_32x32x16_bf16(kf[t], qb[t], s, 0, 0, 0);
    ld_frag(kf, knext, lane);
    __builtin_amdgcn_sched_barrier(0);
    if (active) mb(s);
    tile_update(B, s, vf);
}
__device__ __forceinline__ void tile_store(const QTile& st, bf16_t* orow, int lane) {
    const float lt = st.l + xor32(st.l, lane); const float inv = 1.0f / lt; const int hi = lane >> 5; const int pidx = (lane ^ 32) << 2;
#pragma unroll
    for (int db = 0; db < 2; ++db)
#pragma unroll
        for (int k = 0; k < 2; ++k) { const f32x16& o = db == 0 ? st.o0 : st.o1;
            u32x2 e0, e1;
            e0.x = pk2(o[8 * k] * inv, o[8 * k + 1] * inv); e0.y = pk2(o[8 * k + 2] * inv, o[8 * k + 3] * inv);
            e1.x = pk2(o[8 * k + 4] * inv, o[8 * k + 5] * inv); e1.y = pk2(o[8 * k + 6] * inv, o[8 * k + 7] * inv);
            const u32x2 snd = hi ? e0 : e1; u32x2 rcv;
            rcv.x = (unsigned)__builtin_amdgcn_ds_bpermute(pidx, (int)snd.x); rcv.y = (unsigned)__builtin_amdgcn_ds_bpermute(pidx, (int)snd.y);
            const u32x4 w = hi ? (u32x4){rcv.x, rcv.y, e1.x, e1.y} : (u32x4){e0.x, e0.y, rcv.x, rcv.y};
            *(u32x4*)(orow + 32 * db + 16 * k + 8 * hi) = w; }
}
__device__ __forceinline__ void attn_even_unit(int wu, const bf16_t* T0, const bf16_t* KF, const bf16_t* KFC, const bf16_t* VF, const bf16_t* VFC, const float* sink, const float* qg, const float* kg, bf16_t* A2, int lane) {
    const bool isctx = wu >= 2048; int b, qt, hp;
    if (!isctx) { hp = wu & 3; qt = (wu >> 2) & 127; b = wu >> 9; } else { const int w2 = wu - 2048; hp = w2 & 3; qt = (w2 >> 2) & 7; b = w2 >> 5; }
    const int kvh = hp >> 1, hi = lane >> 5, ql = lane & 31, hA = 2 * hp;
    const int qrow = isctx ? ML + b * CTXL + 32 * qt + ql : b * SEQ + 32 * qt + ql;
    bf16x8 qa[4], qb[4];
    { const bf16_t* qp = T0 + (size_t)qrow * EVIN + 512 + 64 * hA + 8 * hi;
#pragma unroll
      for (int t = 0; t < 4; ++t) { qa[t] = *(const bf16x8*)(qp + 16 * t); qb[t] = *(const bf16x8*)(qp + 64 + 16 * t); } }
    const float m0 = SC_L2 * 64.0f * 1.02f * wave_max(fabsf(qg[lane]), lane) * wave_max(fabsf(kg[lane]), lane) + 0.25f;
    QTile A, B; tile_init(A, hi == 0 ? __builtin_amdgcn_exp2f(sink[hA] * LOG2E - m0) : 0.0f); tile_init(B, hi == 0 ? __builtin_amdgcn_exp2f(sink[hA + 1] * LOG2E - m0) : 0.0f);
    const int bh = b * 2 + kvh;
    const bf16_t* kc = KFC + (size_t)(bh * 8) * 2048; const bf16_t* vc = VFC + (size_t)(bh * 8) * 2048;
    int jlo = 0, nwin = 0; const int q0 = 32 * qt;
    if (!isctx) { jlo = q0 >= 128 ? 0 : (128 - q0) >> 5; const int jhi = min(8, (4192 - q0) >> 5); nwin = jhi - jlo + 1; }
    const bf16_t* kw = KF + ((size_t)bh * 128 + (size_t)((q0 - 128 + 32 * jlo) >> 5)) * 2048; const bf16_t* vw = VF + ((size_t)bh * 128 + (size_t)((q0 - 128 + 32 * jlo) >> 5)) * 2048;
    const int nblk = 8 + nwin;
    bf16x8 kf[4], vf[4];
    ld_frag(kf, kc, lane);
#pragma unroll 1
    for (int j = 0; j < nblk; ++j) {
        const int jn = j + 1 < nblk ? j + 1 : j;
        const bf16_t* knext = jn < 8 ? kc + (size_t)jn * 2048 : kw + (size_t)(jn - 8) * 2048;
        ld_frag(vf, j < 8 ? vc + (size_t)j * 2048 : vw + (size_t)(j - 8) * 2048, lane);
        const int jj = j - 8 + jlo;
        const bool act = j >= 8 && (jj == 0 || jj == 8); const WinMask wm{ql, hi, jj == 0};
        attn_step(A, B, qa, qb, kf, vf, wm, wm, act, -m0, lane, knext);
    }
    bf16_t* orow = A2 + (size_t)qrow * KOUT0 + 1024 + 64 * hA;
    tile_store(A, orow, lane); tile_store(B, orow + 64, lane);
}
__device__ __forceinline__ void attn_odd_unit(int wu, const bf16_t* T1, const bf16_t* KF, const bf16_t* KFC, const bf16_t* VF, const bf16_t* VFC, const float* rel_bias, const float* qg, const float* kg, bf16_t* A2, LAS float* tbl, int& hprev, float& m0s, int lane) {
    const int r = wu & 63, h = (wu >> 6) & 15, b = wu >> 10;
    const int hi = lane >> 5, ql = lane & 31;
    if (h != hprev) {
        asm volatile("s_waitcnt lgkmcnt(0)" ::: "memory");
        float bmx = 0.f;
#pragma unroll 6
        for (int idx = lane; idx < 1920; idx += 64) { const int dr = idx >> 7, dc = (idx & 127) - 48; const int dcc = min(max(dc, 0), 30); const float ld = rel_bias[h * 465 + dr * 31 + dcc] * LOG2E; const float bv = (dc == dcc) ? ld : 0.f; tbl[idx] = bv; bmx = fmaxf(bmx, bv); }
        m0s = SC_L2 * 64.0f * 1.02f * wave_max(fabsf(qg[lane]), lane) * wave_max(fabsf(kg[lane]), lane) + wave_max(bmx, lane) + 0.25f;
        hprev = h;
    }
    const float m0 = m0s;
    asm volatile("s_waitcnt lgkmcnt(0)" ::: "memory");
    const int qrow = b * SEQ + r * 64 + ql;
    bf16x8 qa[4], qb[4];
    { const bf16_t* qp = T1 + (size_t)qrow * ODIN + 64 * h + 8 * hi;
#pragma unroll
      for (int t = 0; t < 4; ++t) { qa[t] = *(const bf16x8*)(qp + 16 * t); qb[t] = *(const bf16x8*)(qp + (size_t)32 * ODIN + 16 * t); } }
    QTile A, B; tile_init(A, 0.f); tile_init(B, 0.f);
    const int bh = b * 16 + h; const int r0 = min(max(r - 4, 0), 56);
    const int c0a = max(ql - 8, 0), c0b = min(24 + ql, 48);
    const bf16_t* kc = KFC + (size_t)(bh * 8) * 2048; const bf16_t* vc = VFC + (size_t)(bh * 8) * 2048;
    const bf16_t* kw = KF + ((size_t)bh * 128 + (size_t)(r0 * 2)) * 2048; const bf16_t* vw = VF + ((size_t)bh * 128 + (size_t)(r0 * 2)) * 2048;
    bf16x8 kf[4], vf[4];
    ld_frag(kf, kc, lane);
#pragma unroll 1
    for (int j = 0; j < 24; ++j) {
        const int jn = j + 1 < 24 ? j + 1 : j;
        const bf16_t* knext = jn < 8 ? kc + (size_t)jn * 2048 : kw + (size_t)(jn - 8) * 2048;
        ld_frag(vf, j < 8 ? vc + (size_t)j * 2048 : vw + (size_t)(j - 8) * 2048, lane);
        const int jj = j < 8 ? 0 : j - 8, rr = r0 + (jj >> 1), kbk = jj & 1; const LAS float* trow = tbl + (rr - r + 7) * 128 + 63 + 32 * kbk + 4 * hi;
        const NaMask ma{trow - ql, 32 * kbk + 4 * hi - c0a}, mb{trow - 32 - ql, 32 * kbk + 4 * hi - c0b};
        attn_step(A, B, qa, qb, kf, vf, ma, mb, j >= 8, -m0, lane, knext);
    }
    bf16_t* orow = A2 + (size_t)qrow * DM + 64 * h;
    tile_store(A, orow, lane); tile_store(B, orow + (size_t)32 * DM, lane);
}

template <bool RES_F32, int S>
__device__ __forceinline__ void ctx_fixup(const float* part, const void* res_ctx, bf16_t* xs_ctx, const float* gate4, const float* gam4, bf16_t* xn_ctx, float* rss_ctx, int gw, int ngw, int lane) {
    for (int rl = gw; rl < MC; rl += ngw) { float ss = 0.f;
#pragma unroll
        for (int h = 0; h < 2; ++h) { const int col = 8 * lane + 512 * h; unsigned wx[4], wn[4];
#pragma unroll
            for (int q = 0; q < 2; ++q) { const int c = col + 4 * q; f32x4 acc = {0.f, 0.f, 0.f, 0.f};
                f32x4 pv[S];
#pragma unroll
                for (int s = 0; s < S; ++s) pv[s] = *(const f32x4*)(part + ((size_t)s * 1024 + rl) * 1024 + c);
#pragma unroll
                for (int s = 0; s < S; ++s) acc += pv[s];
                f32x4 r;
                if (RES_F32) r = *(const f32x4*)((const float*)res_ctx + (size_t)rl * DM + c);
                else { const u32x2 rb = *(const u32x2*)((const bf16_t*)res_ctx + (size_t)rl * DM + c); r = (f32x4){bflo(rb.x), bfhi(rb.x), bflo(rb.y), bfhi(rb.y)}; }
                const f32x4 x = r + *(const f32x4*)(gate4 + c) * acc;
                wx[2 * q] = pk2(x.x, x.y); wx[2 * q + 1] = pk2(x.z, x.w); ss += (x.x * x.x + x.y * x.y) + (x.z * x.z + x.w * x.w);
                const f32x4 y = x * *(const f32x4*)(gam4 + c); wn[2 * q] = pk2(y.x, y.y); wn[2 * q + 1] = pk2(y.z, y.w); }
            *(u32x4*)(xs_ctx + (size_t)rl * DM + col) = (u32x4){wx[0], wx[1], wx[2], wx[3]};
            *(u32x4*)(xn_ctx + (size_t)rl * DM + col) = (u32x4){wn[0], wn[1], wn[2], wn[3]}; }
        ss = wave_sum(ss, lane); if (lane == 0) rss_ctx[rl] = ss; }
}
#define RLX_AGENT __ATOMIC_RELAXED, __HIP_MEMORY_SCOPE_AGENT
#define XB_TMO      128
#define XB_XCNT(j)  (256  + 64 * (j))
#define XB_XSUB(j)  (1280 + 64 * (j))
#define XB_XGEN(j)  (2304 + 64 * (j))
#define XB_TOP      3328
#define XB_TOPGEN   3392
#define XCD_BAR_WORDS 3456
#define XB_SPIN_CAP (1u << 18)

__device__ __forceinline__ unsigned xb_ld(unsigned* p)              { return __hip_atomic_load(p, __ATOMIC_RELAXED, __HIP_MEMORY_SCOPE_AGENT); }
__device__ __forceinline__ unsigned xb_add(unsigned* p, unsigned v) { return __hip_atomic_fetch_add(p, v, __ATOMIC_RELAXED, __HIP_MEMORY_SCOPE_AGENT); }
__device__ __forceinline__ unsigned xb_xcc_id() { return (unsigned)__builtin_amdgcn_s_getreg((3 << 11) | 20) & 0xFu; }
#define XB_SPIN(cond, bar) do { unsigned _sp = 0; while (cond) { __builtin_amdgcn_s_sleep(1); \
    if ((++_sp & 255u) == 0u) { if (xb_ld(&(bar)[XB_TMO])) break; if (_sp > XB_SPIN_CAP) { atomicAdd(&(bar)[XB_TMO], 1u); break; } } } } while (0)

struct XcdBarrier {
    unsigned* bar; unsigned x;
    volatile LAS unsigned* st;
};

__device__ __forceinline__ XcdBarrier xcd_barrier_post(unsigned* bar, volatile LAS unsigned* st, const bool leader) {
    XcdBarrier b; b.bar = bar; b.x = xb_xcc_id(); b.st = st;
    if (leader) (void)xb_add(&bar[XB_XCNT(b.x)], 1u);
    return b;
}
__device__ __forceinline__ void xcd_barrier_complete(unsigned* bar, unsigned x, unsigned& nloc, unsigned& nx) {
    const unsigned G = gridDim.x * gridDim.y * gridDim.z;
    unsigned sum, cnt, mine, sp = 0u;
    for (;;) {
        sum = 0u; cnt = 0u; mine = 0u;
#pragma unroll
        for (unsigned j = 0; j < 16; ++j) { const unsigned c = xb_ld(&bar[XB_XCNT(j)]); sum += c; cnt += (c > 0u) ? 1u : 0u; mine = (j == x) ? c : mine; }
        if (sum == G) break;
        __builtin_amdgcn_s_sleep(1);
        if ((++sp & 255u) == 0u) { if (xb_ld(&bar[XB_TMO])) break; if (sp > XB_SPIN_CAP) { atomicAdd(&bar[XB_TMO], 1u); break; } }
    }
    nloc = mine > 0u ? mine : 1u; nx = cnt > 0u ? cnt : 1u;
}

__device__ __forceinline__ void xcd_barrier(const XcdBarrier& b, const bool leader) {
    asm volatile("s_waitcnt vmcnt(0)" ::: "memory");
    __syncthreads();
    if (leader) {
        unsigned* bar = b.bar;
        __builtin_amdgcn_s_waitcnt(0);
        unsigned nloc = b.st[0], nx = b.st[1];
        if (nloc == 0u) { xcd_barrier_complete(bar, b.x, nloc, nx); b.st[0] = nloc; b.st[1] = nx; }
        const unsigned old = xb_add(&bar[XB_XSUB(b.x)], 1u);
        const unsigned gen = old / nloc;
        if (old + 1u == (gen + 1u) * nloc) {
            __builtin_amdgcn_fence(__ATOMIC_RELEASE, "agent");
            asm volatile("s_waitcnt vmcnt(0)" ::: "memory");
            const unsigned og = xb_add(&bar[XB_TOP], 1u);
            const unsigned tg = og / nx;
            if (og + 1u == (tg + 1u) * nx) xb_add(&bar[XB_TOPGEN], 1u);
            else XB_SPIN(xb_ld(&bar[XB_TOPGEN]) == tg, bar);
            __builtin_amdgcn_fence(__ATOMIC_ACQUIRE, "agent");
            xb_add(&bar[XB_XGEN(b.x)], 1u);
            asm volatile("s_waitcnt vmcnt(0)" ::: "memory");
        } else {
            XB_SPIN(xb_ld(&bar[XB_XGEN(b.x)]) == gen, bar);
            __builtin_amdgcn_fence(__ATOMIC_ACQUIRE, "agent");
            asm volatile("s_waitcnt vmcnt(0)" ::: "memory");
        }
    }
    __syncthreads();
}

constexpr int MISC_OFF = 148 * 1024;
#define GRID_BAR() do { int zb_ = 0; asm volatile("" : "+s"(zb_)); const bool leader_ = (wave_s == 0) && (__builtin_amdgcn_mbcnt_hi(~0u, __builtin_amdgcn_mbcnt_lo(~0u, zb_)) == 0); XcdBarrier xb_; xb_.bar = (unsigned*)WSP; xb_.x = xb_xcc_id(); xb_.st = (volatile LAS unsigned*)(lds + MISC_OFF); xcd_barrier(xb_, leader_); } while (0)

#define KARG(i) (*(void* const volatile __attribute__((address_space(4)))*)((const __attribute__((address_space(4))) char*)__builtin_amdgcn_kernarg_segment_ptr() + 8 * (i)))
#define INF(i) ((const float*)KARG(i))
#define WSP ((unsigned char*)KARG(22))
#define OUTP ((unsigned char*)KARG(21))
#define IDS int z_ = 0; asm volatile("" : "+s"(z_)); const int lane = __builtin_amdgcn_mbcnt_hi(~0u, __builtin_amdgcn_mbcnt_lo(~0u, z_)), wave = wave_s, tid = wave * 64 + lane; (void)tid; const int gw = bx * NWAVES + wave, ngw = G * NWAVES; (void)lane; (void)gw; (void)ngw;
__global__ void __launch_bounds__(NTHR, 2) mega_fwd(Params P) {
    extern __shared__ __attribute__((aligned(16))) unsigned char lds_raw[];
    LAS unsigned char* lds = (LAS unsigned char*)lds_raw;
    cg::grid_group grid = cg::this_grid();
    const int G = gridDim.x, bx = blockIdx.x, wave_s = __builtin_amdgcn_readfirstlane(threadIdx.x >> 6);
    { IDS if (tid < 2) ((volatile LAS unsigned*)(lds + MISC_OFF))[tid] = 0u;
      (void)xcd_barrier_post((unsigned*)WSP, (volatile LAS unsigned*)(lds + MISC_OFF), wave == 0 && lane == 0); }
    { IDS unsigned char* ws = WSP; float* mod = (float*)(ws + WS_MOD);
      { float* rss = (float*)(ws + WS_RSS); const int gi = bx * NTHR + tid; if (gi < 3 * MT) rss[gi] = 0.f; if (G * NTHR < 3 * MT) for (int i = gi + G * NTHR; i < 3 * MT; i += G * NTHR) rss[i] = 0.f; }
      for (int it = bx; it < 96 + 256; it += G) {
          int item = it;
          if (G >= 256) { if (bx < 96) { if (it != bx) break; } else { item = -1; } }
          if (item >= 0) { if (item < 96) adaln_unit(lds, INF(1), INF(3), INF(4), INF(5), mod, item, tid); else fourier_w_item(lds, INF(12), (bf16_t*)(ws + WS_WOUT0), item - 96, tid); }
          else break;
      }
      if (G >= 256 && bx >= 96) for (int it = bx - 96; it < 256; it += G - 96) fourier_w_item(lds, INF(12), (bf16_t*)(ws + WS_WOUT0), it, tid);
      if (bx == G - 1) { float* rope = (float*)(ws + WS_ROPE); for (int i = tid; i < 1024; i += NTHR) { const int coord = i >> 4, fi = i & 15; const float inv = __builtin_amdgcn_exp2f(-(float)fi * (13.287712379549449f / 16.0f));
        float r = (float)coord * inv * 0.15915494309189535f; r -= floorf(r); rope[2 * i] = cos_rev(r); rope[2 * i + 1] = sin_rev(r); } }
      __syncthreads();
    }
    { IDS unsigned char* ws = WSP; LAS float* tile = (LAS float*)lds;
        const int skip = (G == 256) ? 96 : 0;
        if (bx >= skip) { const int step = G - skip; int it = bx - skip; f32x4 v[8];
            if (it < 112) tr_load(tdesc0(it, INF(11), INF(12), INF(8), INF(9), INF(10), ws), v, tid);
            while (it < 112) { const int nx = it + step; const TDesc d = tdesc0(it, INF(11), INF(12), INF(8), INF(9), INF(10), ws);
                tr_stage(v, tile, tid); __syncthreads();
                if (nx < 112) tr_load(tdesc0(nx, INF(11), INF(12), INF(8), INF(9), INF(10), ws), v, tid);
                tr_store(d, tile, tid); __syncthreads(); it = nx; } }
    }
    if (G == 0x7fffffff) grid.sync();
    GRID_BAR();
    { IDS unsigned char* ws = WSP; const float* mod = (const float*)(ws + WS_MOD);
      { const int i = bx * NTHR + tid; if (i < 15360) { const int gi = i / 5120, v = (i >> 10) % 5, col = i & 1023; float g, sc;
            if (gi == 0) { g = INF(7)[col]; sc = mod[(size_t)v * 6144 + 4096 + col]; } else if (gi == 1) { g = INF(6)[DM + col]; sc = mod[(size_t)(5 + v) * 6144 + 1024 + col]; } else { g = INF(7)[DM + col]; sc = mod[(size_t)(5 + v) * 6144 + 4096 + col]; }
            ((float*)(ws + WS_GAM))[i] = g * (1.0f + sc); } }
      rms_mod_rows(INF(0), INF(2), MT, INF(6), mod, 0, 1024, (bf16_t*)(ws + WS_XN), gw, ngw, lane); }
    GRID_BAR();
    {
        unsigned char* ws = WSP; bf16_t* T0 = (bf16_t*)(ws + WS_T0);
        pg8::Gemm g{(bf16_t*)(ws + WS_XN), (bf16_t*)(ws + WS_WIN0), MT, EVIN, DM}; pg8::StaticOrder S; S.init(MT, EVIN, G, bx, DM); pg8::EpiBf16 E{T0, EVIN};
        pg8::gemm_phase<pg8::EpiBf16, pg8::StaticOrder, true, true>(lds, g, S, E, wave_s);
        IDS unsigned char* dob = OUTP;
        pg8::Unit u; for (int i = 0; S.next(i, u); ++i) post_unit<0>(u, T0, INF(13), INF(14), (const float*)(ws + WS_ROPE), (bf16_t*)(dob), (bf16_t*)(dob + 8 * MiB), (bf16_t*)(dob + 4 * MiB), (bf16_t*)(dob + 8 * MiB + 512 * 1024), lds, tid);
    }
    {
        IDS unsigned char* ws = WSP; LAS float* tile = (LAS float*)lds;
        const int skip = (G == 256) ? 84 : 0;
        __syncthreads();
        if (bx >= skip) { constexpr int NIT0 = 640 - 112, NIT1 = 8 * (ODIN / 128) + 64 + 3 * 8 * (DFF / 128), NITT = NIT0 + NIT1; const int step = G - skip; int it = bx - skip;
            f32x4 v[8];
#define TD_(i_) ((i_) < NIT0 ? tdesc0(112 + (i_), INF(11), INF(12), INF(8), INF(9), INF(10), ws) : tdesc1((i_) - NIT0, INF(16), INF(17), INF(8), INF(9), INF(10), ws))
            if (it < NITT) tr_load(TD_(it), v, tid);
            while (it < NITT) { const int nx = it + step; const TDesc d = TD_(it);
                tr_stage(v, tile, tid); __syncthreads();
                if (nx < NITT) tr_load(TD_(nx), v, tid);
                tr_store(d, tile, tid); __syncthreads();
                it = nx; }
#undef TD_
        }
    }
    GRID_BAR();
    {
        IDS unsigned char* ws = WSP; bf16_t *T0 = (bf16_t*)(ws + WS_T0), *A20 = (bf16_t*)(ws + WS_A20);
        for (int s0 = bx; s0 < 256; s0 += G) { const int s = (G == 256) ? ((s0 & 7) * 32 + (s0 >> 3)) : s0; fft_slab(lds, T0, A20, s, tid); }
    }
    {   IDS unsigned char* ws = WSP; bf16_t *T0 = (bf16_t*)(ws + WS_T0), *A20 = (bf16_t*)(ws + WS_A20);
        for (int s0 = bx; s0 < 256; s0 += G) { const int s = (G == 256) ? ((s0 & 7) * 32 + (s0 >> 3)) : s0; ctxdft_slab(lds, T0, A20, s, tid); }
    }
    {
        IDS unsigned char* ws = WSP; unsigned char* dob = OUTP; bf16_t *T0 = (bf16_t*)(ws + WS_T0), *A20 = (bf16_t*)(ws + WS_A20);
        const bf16_t *KF0 = (bf16_t*)(dob), *VF0 = (bf16_t*)(dob + 4 * MiB), *KFC0 = (bf16_t*)(dob + 8 * MiB), *VFC0 = (bf16_t*)(dob + 8 * MiB + 512 * 1024);
        const int vcu = (G % 8 == 0) ? (bx & 7) * (G >> 3) + (bx >> 3) : bx; const int gwv = vcu * NWAVES + wave;
        int wu = gwv; bool extra = false;
        for (;;) {
            if (!extra) { if (wu >= 2048) { extra = true; if ((gwv & 15) != 0) break; wu = 2048 + (gwv >> 4); continue; } }
            else if (wu >= 2176) break;
            attn_even_unit(wu, T0, KF0, KFC0, VF0, VFC0, INF(15), INF(13), INF(14), A20, lane);
            wu += extra ? (ngw >> 4) : ngw;
        }
    }
    GRID_BAR();
    {
        unsigned char* ws = WSP; bf16_t* XS = (bf16_t*)(ws + WS_XS);
        pg8::Gemm g{(bf16_t*)(ws + WS_A20), (bf16_t*)(ws + WS_WOUT0), MT, DM, KOUT0}; pg8::TailSplitOrder S; S.init(ML, MT, DM, G, bx, KOUT0, 6);
        pg8::EpiResGateN<true> E{INF(0), INF(2), XS, XS + (size_t)ML * DM, (const float*)(ws + WS_MOD) + 2048, (const float*)(ws + WS_GAM), (bf16_t*)(ws + WS_XN), (float*)(ws + WS_RSS), (float*)(ws + WS_T0), KOUT0 / 64};
        pg8::gemm_phase<pg8::EpiResGateN<true>, pg8::TailSplitOrder, true, true>(lds, g, S, E, wave_s);
    }
    { IDS unsigned char* ws = WSP; const int skip = (G == 256) ? 96 : 0;
      if (bx >= skip) bias_rows((const bf16_t*)(ws + WS_WGU0), NGU, (const float*)(ws + WS_MOD) + 3072, (float*)(ws + WS_BIAS), (bx - skip) * NWAVES + wave, (G - skip) * NWAVES, lane); }
    GRID_BAR();
    {   IDS unsigned char* ws = WSP; bf16_t* XS = (bf16_t*)(ws + WS_XS);
        ctx_fixup<true, 6>((const float*)(ws + WS_T0), INF(2), XS + (size_t)ML * DM, (const float*)(ws + WS_MOD) + 4 * 6144 + 2048, (const float*)(ws + WS_GAM) + 4 * DM, (bf16_t*)(ws + WS_XN) + (size_t)ML * DM, (float*)(ws + WS_RSS) + ML, gw, ngw, lane);
    }
    GRID_BAR();
    {   unsigned char* ws = WSP; pg8::Gemm g{(bf16_t*)(ws + WS_XN), (bf16_t*)(ws + WS_WGU0), MT, NGU, DM}; pg8::StaticOrder S; S.init(MT, NGU, G, bx, DM); pg8::EpiSwiGLUN E{(bf16_t*)(ws + WS_BIG), (const float*)(ws + WS_RSS), (const float*)(ws + WS_BIAS)};
        pg8::gemm_phase<pg8::EpiSwiGLUN, pg8::StaticOrder, true, true>(lds, g, S, E, wave_s); }
    GRID_BAR();
    {   unsigned char* ws = WSP; bf16_t* XS = (bf16_t*)(ws + WS_XS);
        pg8::Gemm g{(bf16_t*)(ws + WS_BIG), (bf16_t*)(ws + WS_WD0), MT, DM, DFF}; pg8::TailSplitOrder S; S.init(ML, MT, DM, G, bx, DFF, 11);
        pg8::EpiResGateN<false> E{XS, XS + (size_t)ML * DM, XS, XS + (size_t)ML * DM, (const float*)(ws + WS_MOD) + 5120, (const float*)(ws + WS_GAM) + 5 * DM, (bf16_t*)(ws + WS_XN), (float*)(ws + WS_RSS) + MT, (float*)OUTP, DFF / 64};
        pg8::gemm_phase<pg8::EpiResGateN<false>, pg8::TailSplitOrder, true, true>(lds, g, S, E, wave_s); }
    GRID_BAR();
    {   IDS unsigned char* ws = WSP; bf16_t* XS = (bf16_t*)(ws + WS_XS);
        ctx_fixup<false, 11>((const float*)OUTP, XS + (size_t)ML * DM, XS + (size_t)ML * DM, (const float*)(ws + WS_MOD) + 4 * 6144 + 5120, (const float*)(ws + WS_GAM) + 5 * DM + 4 * DM, (bf16_t*)(ws + WS_XN) + (size_t)ML * DM, (float*)(ws + WS_RSS) + MT + ML, gw, ngw, lane);
    }
    {
        IDS unsigned char* ws = WSP; const float* mod = (const float*)(ws + WS_MOD); float* bias = (float*)(ws + WS_BIAS);
        const int skip = 0;
        if (bx >= skip) { const int gw2 = (bx - skip) * NWAVES + wave, ngw2 = (G - skip) * NWAVES;
            bias_rows((const bf16_t*)(ws + WS_WIN1), ODIN, mod + 5 * 6144, bias + 5 * NGU, gw2, ngw2, lane);
            bias_rows((const bf16_t*)(ws + WS_WGU1), NGU, mod + 5 * 6144 + 3072, bias + 5 * NGU + 5 * ODIN, gw2, ngw2, lane); }
    }
    GRID_BAR();
    {   unsigned char* ws = WSP; bf16_t* T1 = (bf16_t*)(ws + WS_BIG);
        pg8::Gemm g{(bf16_t*)(ws + WS_XN), (bf16_t*)(ws + WS_WIN1), MT, ODIN, DM}; pg8::StaticOrder S; S.init(MT, ODIN, G, bx, DM); pg8::EpiBf16N E{T1, ODIN, (const float*)(ws + WS_RSS) + MT, (const float*)(ws + WS_BIAS) + 5 * NGU};
        pg8::gemm_phase<pg8::EpiBf16N, pg8::StaticOrder, true, true>(lds, g, S, E, wave_s);
        IDS unsigned char* dob = OUTP;
        pg8::Unit u; for (int i = 0; S.next(i, u); ++i) post_unit<1>(u, T1, INF(18), INF(19), nullptr, (bf16_t*)(dob), (bf16_t*)(ws + 1 * MiB), (bf16_t*)(dob + 32 * MiB), (bf16_t*)(ws + 3 * MiB), lds, tid);
    }
    GRID_BAR();
    { IDS unsigned char* ws = WSP; unsigned char* dob = OUTP; LAS float* tbl = (LAS float*)(lds + wave * 8192);
      const int vcu = (G % 8 == 0) ? (bx & 7) * (G >> 3) + (bx >> 3) : bx;
      int hprev = -1; float m0s = 0.f;
      for (int wu = vcu * NWAVES + wave; wu < 4096; wu += ngw) attn_odd_unit(wu, (const bf16_t*)(ws + WS_BIG), (const bf16_t*)(dob), (const bf16_t*)(ws + 1 * MiB), (const bf16_t*)(dob + 32 * MiB), (const bf16_t*)(ws + 3 * MiB), INF(20), INF(18), INF(19), (bf16_t*)(ws + WS_XN), tbl, hprev, m0s, lane); }
    GRID_BAR();
    {   unsigned char* ws = WSP; bf16_t* XS = (bf16_t*)(ws + WS_XS);
        pg8::Gemm g{(bf16_t*)(ws + WS_XN), (bf16_t*)(ws + WS_WOUT1), ML, DM, DM}; pg8::StaticOrder S; S.init(ML, DM, G, bx, DM); pg8::EpiResGateN<false> E{XS, XS, XS, XS, (const float*)(ws + WS_MOD) + 5 * 6144 + 2048, (const float*)(ws + WS_GAM) + 10 * DM, (bf16_t*)OUTP, (float*)(ws + WS_RSS) + 2 * MT, nullptr, DM / 64};
        pg8::gemm_phase<pg8::EpiResGateN<false>, pg8::StaticOrder, true, true>(lds, g, S, E, wave_s); }
    GRID_BAR();
    {   unsigned char* ws = WSP; pg8::Gemm g{(bf16_t*)OUTP, (bf16_t*)(ws + WS_WGU1), ML, NGU, DM}; pg8::StaticOrder S; S.init(ML, NGU, G, bx, DM); pg8::EpiSwiGLUN E{(bf16_t*)(ws + WS_BIG), (const float*)(ws + WS_RSS) + 2 * MT, (const float*)(ws + WS_BIAS) + 5 * NGU + 5 * ODIN};
        pg8::gemm_phase<pg8::EpiSwiGLUN, pg8::StaticOrder, true, true>(lds, g, S, E, wave_s); }
    GRID_BAR();
    {   unsigned char* ws = WSP; const bf16_t* XS = (const bf16_t*)(ws + WS_XS); float* outp = (float*)OUTP;
        pg8::Gemm g{(bf16_t*)(ws + WS_BIG), (bf16_t*)(ws + WS_WD1), ML, DM, DFF}; pg8::StaticOrder S; S.init(ML, DM, G, bx, DFF); pg8::EpiResGate E{XS, outp, (const float*)(ws + WS_MOD) + 5 * 6144 + 5120};
        pg8::gemm_phase<pg8::EpiResGate, pg8::StaticOrder, true, true>(lds, g, S, E, wave_s); }
}

extern "C" void kernel_launch(void* const* d_in, const int* in_sizes, int n_in, void* d_out, int out_size, void* d_ws, size_t ws_size, hipStream_t stream) {
    static int grid = 0;
    if (grid == 0) {
        if (n_in != 21 || out_size != ML * DM || ws_size < WS_END) { fprintf(stderr, "kernel_launch: unexpected shapes (n_in %d out %d ws %zu)\n", n_in, out_size, ws_size); grid = -1; return; }
        int dev = 0, cus = 0, per_cu = 0;
        (void)hipGetDevice(&dev); (void)hipDeviceGetAttribute(&cus, hipDeviceAttributeMultiprocessorCount, dev);
        if (hipFuncSetAttribute((const void*)mega_fwd, hipFuncAttributeMaxDynamicSharedMemorySize, LDS_BYTES) != hipSuccess) { fprintf(stderr, "kernel_launch: hipFuncSetAttribute failed\n"); grid = -1; return; }
        if (hipOccupancyMaxActiveBlocksPerMultiprocessor(&per_cu, (const void*)mega_fwd, NTHR, LDS_BYTES) != hipSuccess || per_cu < 1) per_cu = 1;
        (void)hipGetLastError();
        grid = cus * per_cu; if (grid < 1) grid = 256;
    }
    if (grid < 0) return;
    if (hipMemsetAsync(d_ws, 0, 16384, stream) != hipSuccess) { fprintf(stderr, "kernel_launch: hipMemsetAsync of the barrier words failed\n"); return; }
    Params p{};
    const float** pf = (const float**)&p;
    for (int i = 0; i < 21; ++i) pf[i] = (const float*)d_in[i];
    p.out = (float*)d_out; p.ws = (unsigned char*)d_ws;
    void* args[] = {&p};
    hipError_t e = hipLaunchCooperativeKernel((const void*)mega_fwd, dim3(grid), dim3(NTHR), args, LDS_BYTES, stream);
    if (e != hipSuccess) fprintf(stderr, "cooperative launch failed: %s (grid %d)\n", hipGetErrorString(e), grid);
}
```
